# Optimizing an MI355X kernel written in HIP

```python
import math
import jax, jax.numpy as jnp
from jax import lax
import numpy as np

D_MODEL = 2048
BATCH = 4
SEQ = 2048
DEPTH = 4
DEC_BATCH = 32
DEC_SEQ = 1
PAST_LEN = 16384
PAGE_SIZE = 128

N_META = 16
S5_GROUP = 16
S5_WIDTH = D_MODEL // 2
S5_GROUPS = S5_WIDTH // S5_GROUP
S5_STATE = 64
GLA_HEADS = 4
GLA_DK = D_MODEL // 16
GLA_DV = D_MODEL // 8
GLA_RANK = 16
GLA_TAU = 16.0
GLA_CHUNK = 16
SWA_QH = 16
SWA_KVH = 4
SWA_GRP = SWA_QH // SWA_KVH
SWA_HD = 64
WINDOW = 128
N_BUCKETS = 32
MAX_DISTANCE = WINDOW
D_FF = 4 * D_MODEL
N_BRANCH = 3
EPS = 1e-6
IN_SIZES = (S5_WIDTH,
            GLA_HEADS * GLA_DK,
            GLA_HEADS * GLA_DK,
            GLA_HEADS * GLA_DV,
            GLA_RANK,
            GLA_HEADS * GLA_DV,
            SWA_QH * SWA_HD,
            SWA_KVH * SWA_HD,
            SWA_KVH * SWA_HD,
            N_BRANCH * D_MODEL)
IN_WIDTH = sum(IN_SIZES)

kernel_name = 'hybrid_s5_gla_swa_decoder_step'

F32 = jnp.float32


def _rmsnorm(x, g):
    xf = x.astype(F32)
    y = xf * lax.rsqrt(jnp.mean(xf * xf, axis=-1, keepdims=True) + EPS)
    return (y * g.astype(F32)).astype(x.dtype)


def _split_cols(z):
    offs = [0]
    for s in IN_SIZES:
        offs.append(offs[-1] + s)
    return [z[..., a:b] for a, b in zip(offs[:-1], offs[1:])]


def _cplx_combine(e1, e2):
    a1r, a1i, b1r, b1i = e1
    a2r, a2i, b2r, b2i = e2
    return (a1r * a2r - a1i * a2i,
            a1r * a2i + a1i * a2r,
            a2r * b1r - a2i * b1i + b2r,
            a2r * b1i + a2i * b1r + b2i)


def _s5(u, x0_re, x0_im, lam_re, lam_im, log_step, b_re, b_im, c_re, c_im, d_skip, w_glu, b_glu):
    n, t, _ = u.shape
    dt = jnp.exp(log_step.astype(F32))[:, None]
    lr, li = lam_re.astype(F32), lam_im.astype(F32)
    mag = jnp.exp(lr * dt)
    ar, ai = mag * jnp.cos(li * dt), mag * jnp.sin(li * dt)
    den = lr * lr + li * li
    fr = ((ar - 1.0) * lr + ai * li) / den
    fi = (ai * lr - (ar - 1.0) * li) / den
    br, bi = b_re.astype(F32), b_im.astype(F32)
    bbr = fr[..., None] * br - fi[..., None] * bi
    bbi = fr[..., None] * bi + fi[..., None] * br
    uf = u.astype(F32)
    ug = uf.reshape(n, t, S5_GROUPS, S5_GROUP)
    e_re = jnp.einsum('gph,ntgh->tngp', bbr, ug)
    e_im = jnp.einsum('gph,ntgh->tngp', bbi, ug)
    x0r, x0i = x0_re.astype(F32), x0_im.astype(F32)
    e_re = e_re.at[0].add(ar * x0r - ai * x0i)
    e_im = e_im.at[0].add(ar * x0i + ai * x0r)
    a_re = jnp.broadcast_to(ar, (t, 1, S5_GROUPS, S5_STATE))
    a_im = jnp.broadcast_to(ai, (t, 1, S5_GROUPS, S5_STATE))
    _, _, xr, xi = lax.associative_scan(_cplx_combine, (a_re, a_im, e_re, e_im), axis=0)
    y = (jnp.einsum('ghp,tngp->ntgh', c_re.astype(F32), xr)
         - jnp.einsum('ghp,tngp->ntgh', c_im.astype(F32), xi))
    y = y.reshape(n, t, S5_WIDTH) + d_skip.astype(F32) * uf
    z = jax.nn.gelu(y)
    out = z * jax.nn.sigmoid(z @ w_glu.astype(F32) + b_glu.astype(F32))
    return out, xr[-1], xi[-1]


def _gla_chunked(q, k, v, lg, s0):
    n, t, h, _ = q.shape
    nc = t // GLA_CHUNK

    def rs(a):
        return a.reshape(n, nc, GLA_CHUNK, h, a.shape[-1]).transpose(1, 0, 3, 2, 4)

    qc, kc, vc, gc = rs(q), rs(k), rs(v), rs(lg)
    b = jnp.cumsum(gc, axis=3)
    causal = jnp.tril(jnp.ones((GLA_CHUNK, GLA_CHUNK), bool))[..., None]
    diff = b[..., :, None, :] - b[..., None, :, :]
    decay = jnp.exp(jnp.where(causal, diff, -jnp.inf))
    att = jnp.einsum('znhtd,znhsd,znhtsd->znhts', qc, kc, decay)
    intra = jnp.einsum('znhts,znhsv->znhtv', att, vc)
    q_inter = qc * jnp.exp(b)
    k_upd = kc * jnp.exp(b[..., -1:, :] - b)
    chunk_decay = jnp.exp(b[..., -1, :])

    def step(s, inp):
        qi, ku, vi, cd = inp
        o = jnp.einsum('nhtd,nhdv->nhtv', qi, s)
        s = cd[..., None] * s + jnp.einsum('nhsd,nhsv->nhdv', ku, vi)
        return s, o

    s_fin, inter = lax.scan(step, s0, (q_inter, k_upd, vc, chunk_decay))
    o = (intra + inter).transpose(1, 0, 3, 2, 4).reshape(n, t, h, v.shape[-1])
    return o, s_fin


def _gla_recurrent(q, k, v, lg, s0):
    def step(s, inp):
        qt, kt, vt, gt = inp
        s = jnp.exp(gt)[..., None] * s + kt[..., :, None] * vt[..., None, :]
        return s, jnp.einsum('nhd,nhdv->nhv', qt, s)

    tf = lambda a: a.transpose(1, 0, 2, 3)
    s_fin, o = lax.scan(step, s0, (tf(q), tf(k), tf(v), tf(lg)))
    return tf(o), s_fin


def _gla(q, k, v, a_in, r, w_gate2, b_gate2, g_out, s0, prompt):
    n, t, _ = q.shape
    q = q.astype(F32).reshape(n, t, GLA_HEADS, GLA_DK) * (GLA_DK ** -0.5)
    k = k.astype(F32).reshape(n, t, GLA_HEADS, GLA_DK)
    v = v.astype(F32).reshape(n, t, GLA_HEADS, GLA_DV)
    lg = jax.nn.log_sigmoid(a_in.astype(F32) @ w_gate2.astype(F32) + b_gate2.astype(F32)) / GLA_TAU
    lg = lg.reshape(n, t, GLA_HEADS, GLA_DK)
    if prompt:
        o, s = _gla_chunked(q, k, v, lg, s0.astype(F32))
    else:
        o, s = _gla_recurrent(q, k, v, lg, s0.astype(F32))
    o = _rmsnorm(o, g_out).reshape(n, t, GLA_HEADS * GLA_DV)
    return o * jax.nn.silu(r.astype(F32)), s


def _t5_bucket(dist):
    max_exact = N_BUCKETS // 2
    d = jnp.maximum(dist, 0)
    large = max_exact + (jnp.log(jnp.maximum(d, 1).astype(F32) / max_exact)
                         / math.log(MAX_DISTANCE / max_exact) * (N_BUCKETS - max_exact)).astype(jnp.int32)
    large = jnp.minimum(large, N_BUCKETS - 1)
    return jnp.where(d < max_exact, d, large)


def _rel_bias(rel_bias, dist):
    bias = rel_bias.astype(F32)[_t5_bucket(dist)]
    return bias.transpose(2, 0, 1).reshape(SWA_KVH, SWA_GRP, dist.shape[0], dist.shape[1])


def _sink_softmax(s, sink):
    sk = sink.astype(F32).reshape(SWA_KVH, SWA_GRP)[:, :, None, None]
    m = jnp.maximum(jnp.max(s, axis=-1, keepdims=True), sk)
    p = jnp.exp(s - m)
    return p / (jnp.sum(p, axis=-1, keepdims=True) + jnp.exp(sk - m))


def _swa_prompt(q, k, v, rel_bias, sinks):
    n, t, _ = q.shape
    pad = (-t) % WINDOW
    tp = t + pad
    nb = tp // WINDOW
    qf, kf, vf = q.astype(F32), k.astype(F32), v.astype(F32)
    qp = jnp.pad(qf, ((0, 0), (pad, 0), (0, 0))).reshape(n, nb, WINDOW, SWA_KVH, SWA_GRP, SWA_HD)
    kp = jnp.pad(kf, ((0, 0), (pad, 0), (0, 0))).reshape(n, nb, WINDOW, SWA_KVH, SWA_HD)
    vp = jnp.pad(vf, ((0, 0), (pad, 0), (0, 0))).reshape(n, nb, WINDOW, SWA_KVH, SWA_HD)
    shift = lambda a: jnp.pad(a, ((0, 0), (1, 0), (0, 0), (0, 0), (0, 0)))[:, :-1]
    kb = jnp.concatenate([shift(kp), kp], axis=2)
    vb = jnp.concatenate([shift(vp), vp], axis=2)
    s = jnp.einsum('nbqkgd,nbskd->nbkgqs', qp, kb) * (SWA_HD ** -0.5)
    dist = (jnp.arange(WINDOW)[:, None] + WINDOW) - jnp.arange(2 * WINDOW)[None, :]
    band = (dist >= 0) & (dist < WINDOW)
    kabs = jnp.arange(nb)[:, None] * WINDOW - WINDOW + jnp.arange(2 * WINDOW)[None, :]
    mask = band[None] & (kabs >= pad)[:, None, :]
    s = jnp.where(mask[None, :, None, None], s + _rel_bias(rel_bias, dist), -jnp.inf)
    p = _sink_softmax(s, sinks)
    o = jnp.einsum('nbkgqs,nbskd->nbqkgd', p, vb).reshape(n, tp, SWA_QH * SWA_HD)[:, pad:]
    wb = min(WINDOW, t)
    k_last = k.reshape(n, t, SWA_KVH, SWA_HD)[:, t - wb:]
    v_last = v.reshape(n, t, SWA_KVH, SWA_HD)[:, t - wb:]
    return o, k_last, v_last


def _swa_decode(q, k, v, k_buf, v_buf, rel_bias, sinks):
    n, s_new, _ = q.shape
    wb = k_buf.shape[1]
    kk = jnp.concatenate([k_buf, k.reshape(n, s_new, SWA_KVH, SWA_HD).astype(k_buf.dtype)], axis=1)
    vv = jnp.concatenate([v_buf, v.reshape(n, s_new, SWA_KVH, SWA_HD).astype(v_buf.dtype)], axis=1)
    qq = q.astype(F32).reshape(n, s_new, SWA_KVH, SWA_GRP, SWA_HD)
    s = jnp.einsum('nqkgd,nskd->nkgqs', qq, kk.astype(F32)) * (SWA_HD ** -0.5)
    dist = (wb + jnp.arange(s_new)[:, None]) - jnp.arange(wb + s_new)[None, :]
    band = (dist >= 0) & (dist < WINDOW)
    s = jnp.where(band, s + _rel_bias(rel_bias, dist), -jnp.inf)
    p = _sink_softmax(s, sinks)
    o = jnp.einsum('nkgqs,nskd->nqkgd', p, vv.astype(F32)).reshape(n, s_new, SWA_QH * SWA_HD)
    return o, kk[:, s_new:], vv[:, s_new:]


def _mixer(h, lp, rel_bias, st, prompt):
    n, t, _ = h.shape
    dt = h.dtype
    u_a, q_b, k_b, v_b, a_b, r_b, q_c, k_c, v_c, gates = _split_cols(h @ lp['w_in'])
    if prompt:
        s5r0 = jnp.zeros((n, S5_GROUPS, S5_STATE), F32)
        s5i0 = jnp.zeros((n, S5_GROUPS, S5_STATE), F32)
        gla0 = jnp.zeros((n, GLA_HEADS, GLA_DK, GLA_DV), F32)
    else:
        s5r0, s5i0, gla0, k_buf, v_buf = st
    y_a, s5r, s5i = _s5(u_a, s5r0, s5i0, lp['s5_lam_re'], lp['s5_lam_im'], lp['s5_log_step'],
                        lp['s5_b_re'], lp['s5_b_im'], lp['s5_c_re'], lp['s5_c_im'], lp['s5_d'],
                        lp['s5_w_glu'], lp['s5_b_glu'])
    y_b, gla1 = _gla(q_b, k_b, v_b, a_b, r_b, lp['gla_w_gate2'], lp['gla_b_gate2'], lp['gla_g_out'],
                     gla0, prompt)
    if prompt:
        y_c, kn, vn = _swa_prompt(q_c, k_c, v_c, rel_bias, lp['swa_sinks'])
    else:
        y_c, kn, vn = _swa_decode(q_c, k_c, v_c, k_buf, v_buf, rel_bias, lp['swa_sinks'])
    g = jax.nn.sigmoid(gates.astype(F32)).reshape(n, t, N_BRANCH, D_MODEL)
    merged = (g[..., 0, :] * (y_a.astype(dt) @ lp['w_up_s5'])
              + g[..., 1, :] * (y_b.astype(dt) @ lp['w_up_gla'])
              + g[..., 2, :] * (y_c.astype(dt) @ lp['w_up_swa']))
    return merged.astype(dt) @ lp['w_out'], (s5r, s5i, gla1, kn, vn)


def _trunk(x, w, rel_bias, states, prompt):
    new = ([], [], [], [], [])
    for l in range(DEPTH):
        lp = {name: arr[l] for name, arr in w.items()}
        st = None if prompt else tuple(s[l] for s in states)
        h = _rmsnorm(x, lp['norm_pre_mix'])
        mix, ns = _mixer(h, lp, rel_bias, st, prompt)
        x = x + _rmsnorm(mix, lp['norm_post_mix'])
        h = _rmsnorm(x, lp['norm_pre_ffn'])
        ff = jnp.square(jax.nn.relu(h @ lp['w_ff1'])) @ lp['w_ff2']
        x = x + _rmsnorm(ff, lp['norm_post_ffn'])
        for lst, a in zip(new, ns):
            lst.append(a)
    return x, [jnp.stack(a) for a in new]


def setup_inputs(seed: int = 0) -> dict:
    key = jax.random.key(seed)
    ks = iter(jax.random.split(key, 48))
    nrm = lambda shape, scale: jax.random.normal(next(ks), shape, F32) * scale
    wb = min(WINDOW, PAST_LEN)
    d = {}
    d['x_prompt'] = nrm((BATCH, SEQ, D_MODEL), 1.0)
    d['x_sample'] = nrm((DEC_BATCH, DEC_SEQ, D_MODEL), 1.0)
    d['state_s5_re'] = nrm((DEPTH, DEC_BATCH, S5_GROUPS, S5_STATE), 0.1)
    d['state_s5_im'] = nrm((DEPTH, DEC_BATCH, S5_GROUPS, S5_STATE), 0.1)
    d['state_gla'] = nrm((DEPTH, DEC_BATCH, GLA_HEADS, GLA_DK, GLA_DV), 1.0)
    d['cache_swa_k'] = nrm((DEPTH, DEC_BATCH, wb, SWA_KVH, SWA_HD), 1.0)
    d['cache_swa_v'] = nrm((DEPTH, DEC_BATCH, wb, SWA_KVH, SWA_HD), 1.0)
    d['meta_tokens'] = nrm((N_META, D_MODEL), 1.0)
    d['rel_bias'] = nrm((N_BUCKETS, SWA_QH), 0.5)
    for name in ('norm_pre_mix', 'norm_post_mix', 'norm_pre_ffn', 'norm_post_ffn'):
        d[name] = 1.0 + nrm((DEPTH, D_MODEL), 0.05)
    d['w_in'] = nrm((DEPTH, D_MODEL, IN_WIDTH), D_MODEL ** -0.5)
    d['s5_lam_re'] = -0.5 + nrm((DEPTH, S5_GROUPS, S5_STATE), 0.01)
    d['s5_lam_im'] = (jnp.pi * jnp.arange(S5_STATE, dtype=F32))[None, None, :] + nrm((DEPTH, S5_GROUPS, S5_STATE), 0.01)
    d['s5_log_step'] = jax.random.uniform(next(ks), (DEPTH, S5_GROUPS), F32, math.log(1e-3), math.log(1e-1))
    d['s5_b_re'] = nrm((DEPTH, S5_GROUPS, S5_STATE, S5_GROUP), (2.0 * S5_GROUP) ** -0.5)
    d['s5_b_im'] = nrm((DEPTH, S5_GROUPS, S5_STATE, S5_GROUP), (2.0 * S5_GROUP) ** -0.5)
    d['s5_c_re'] = nrm((DEPTH, S5_GROUPS, S5_GROUP, S5_STATE), (2.0 * S5_STATE) ** -0.5)
    d['s5_c_im'] = nrm((DEPTH, S5_GROUPS, S5_GROUP, S5_STATE), (2.0 * S5_STATE) ** -0.5)
    d['s5_d'] = nrm((DEPTH, S5_WIDTH), 1.0)
    d['s5_w_glu'] = nrm((DEPTH, S5_WIDTH, S5_WIDTH), S5_WIDTH ** -0.5)
    d['s5_b_glu'] = nrm((DEPTH, S5_WIDTH), 0.01)
    d['gla_w_gate2'] = nrm((DEPTH, GLA_RANK, GLA_HEADS * GLA_DK), GLA_RANK ** -0.5)
    d['gla_b_gate2'] = 1.0 + nrm((DEPTH, GLA_HEADS * GLA_DK), 0.5)
    d['gla_g_out'] = 1.0 + nrm((DEPTH, GLA_DV), 0.05)
    d['swa_sinks'] = nrm((DEPTH, SWA_QH), 0.5)
    d['w_up_s5'] = nrm((DEPTH, S5_WIDTH, D_MODEL), S5_WIDTH ** -0.5)
    d['w_up_gla'] = nrm((DEPTH, GLA_HEADS * GLA_DV, D_MODEL), (GLA_HEADS * GLA_DV) ** -0.5)
    d['w_up_swa'] = nrm((DEPTH, SWA_QH * SWA_HD, D_MODEL), (SWA_QH * SWA_HD) ** -0.5)
    d['w_out'] = nrm((DEPTH, D_MODEL, D_MODEL), D_MODEL ** -0.5)
    d['w_ff1'] = nrm((DEPTH, D_MODEL, D_FF), D_MODEL ** -0.5)
    d['w_ff2'] = nrm((DEPTH, D_FF, D_MODEL), D_FF ** -0.5)
    return d


def reference(x_prompt, x_sample, state_s5_re, state_s5_im, state_gla, cache_swa_k, cache_swa_v,
              meta_tokens, rel_bias, norm_pre_mix, norm_post_mix, norm_pre_ffn, norm_post_ffn,
              w_in, s5_lam_re, s5_lam_im, s5_log_step, s5_b_re, s5_b_im, s5_c_re, s5_c_im, s5_d,
              s5_w_glu, s5_b_glu, gla_w_gate2, gla_b_gate2, gla_g_out, swa_sinks,
              w_up_s5, w_up_gla, w_up_swa, w_out, w_ff1, w_ff2):
    w = {'norm_pre_mix': norm_pre_mix, 'norm_post_mix': norm_post_mix,
         'norm_pre_ffn': norm_pre_ffn, 'norm_post_ffn': norm_post_ffn,
         'w_in': w_in, 's5_lam_re': s5_lam_re, 's5_lam_im': s5_lam_im, 's5_log_step': s5_log_step,
         's5_b_re': s5_b_re, 's5_b_im': s5_b_im, 's5_c_re': s5_c_re, 's5_c_im': s5_c_im,
         's5_d': s5_d, 's5_w_glu': s5_w_glu, 's5_b_glu': s5_b_glu,
         'gla_w_gate2': gla_w_gate2, 'gla_b_gate2': gla_b_gate2, 'gla_g_out': gla_g_out,
         'swa_sinks': swa_sinks, 'w_up_s5': w_up_s5, 'w_up_gla': w_up_gla, 'w_up_swa': w_up_swa,
         'w_out': w_out, 'w_ff1': w_ff1, 'w_ff2': w_ff2}
    b = x_prompt.shape[0]
    meta = jnp.broadcast_to(meta_tokens.astype(x_prompt.dtype)[None], (b, N_META, D_MODEL))
    xp = jnp.concatenate([meta, x_prompt], axis=1)
    yp_full, pst = _trunk(xp, w, rel_bias, None, True)
    y_prompt = yp_full[:, N_META:]
    y_sample, sst = _trunk(x_sample, w, rel_bias,
                           (state_s5_re, state_s5_im, state_gla, cache_swa_k, cache_swa_v), False)
    p_s5_re, p_s5_im, p_gla, p_swa_k, p_swa_v = pst
    s_s5_re, s_s5_im, s_gla, s_swa_k, s_swa_v = sst
    return (y_prompt, y_sample, p_s5_re, p_s5_im, p_gla, p_swa_k, p_swa_v,
            s_s5_re, s_s5_im, s_gla, s_swa_k, s_swa_v)
```

```cpp
#include <hip/hip_runtime.h>
#include <cstdio>
#include <cstdint>
#include <cstddef>

#define LAS __attribute__((address_space(3)))
typedef unsigned short bf16_t;
typedef short bf16x8 __attribute__((ext_vector_type(8)));
typedef float f32x4 __attribute__((ext_vector_type(4)));
typedef float f32x2 __attribute__((ext_vector_type(2)));
typedef unsigned u32x4 __attribute__((ext_vector_type(4)));
typedef unsigned u32x2 __attribute__((ext_vector_type(2)));

constexpr int D = 2048, NB = 4, SEQ = 2048, NMETA = 16, TP = SEQ + NMETA, NDEC = 32, DEPTH = 4;
constexpr int ROWS_P = NB * TP;
constexpr int MREAL = ROWS_P + NDEC;
constexpr int MP = 8448;
constexpr int INW = 11792, ZW = 11776;
constexpr int ZU = 0, ZQB = 1024, ZKB = 1536, ZVB = 2048, ZRB = 3072, ZQC = 4096, ZKC = 5120, ZVC = 5376, ZG = 5632;
constexpr int DFF = 8192;
constexpr float EPS = 1e-6f;

enum { I_XP = 0, I_XS, I_S5R, I_S5I, I_GLA, I_CK, I_CV, I_META, I_RELB, I_NPM, I_NQM, I_NPF, I_NQF, I_WIN, I_LRE, I_LIM, I_LSTEP, I_BRE, I_BIM, I_CRE, I_CIM, I_SD, I_WGLU, I_BGLU,
       I_WG2, I_BG2, I_GOUT, I_SINK, I_WUS5, I_WUGLA, I_WUSWA, I_WOUT, I_WFF1, I_WFF2, N_IN };

constexpr size_t O_YP = 0, O_YS = O_YP + (size_t)NB * SEQ * D, O_PS5R = O_YS + (size_t)NDEC * D, O_PS5I = O_PS5R + (size_t)DEPTH * NB * 4096,
                 O_PGLA = O_PS5I + (size_t)DEPTH * NB * 4096, O_PSWK = O_PGLA + (size_t)DEPTH * NB * 4 * 128 * 256, O_PSWV = O_PSWK + (size_t)DEPTH * NB * 128 * 256,
                 O_SS5R = O_PSWV + (size_t)DEPTH * NB * 128 * 256, O_SS5I = O_SS5R + (size_t)DEPTH * NDEC * 4096, O_SGLA = O_SS5I + (size_t)DEPTH * NDEC * 4096,
                 O_SSWK = O_SGLA + (size_t)DEPTH * NDEC * 4 * 128 * 256, O_SSWV = O_SSWK + (size_t)DEPTH * NDEC * 128 * 256, O_END = O_SSWV + (size_t)DEPTH * NDEC * 128 * 256;

constexpr size_t al256(size_t x) { return (x + 255) & ~(size_t)255; }
constexpr size_t WS_CTL = 0, WS_CTL_BYTES = 65536;
constexpr size_t WS_WIN = WS_CTL + WS_CTL_BYTES;
constexpr size_t WS_WGLU = WS_WIN + (size_t)DEPTH * ZW * D * 2;
constexpr size_t WS_WUP = WS_WGLU + (size_t)DEPTH * 1024 * 1024 * 2;
constexpr size_t WS_WOUT = WS_WUP + (size_t)DEPTH * 3 * 2048 * 1024 * 2;
constexpr size_t WS_WFF1 = WS_WOUT + (size_t)DEPTH * 2048 * 2048 * 2;
constexpr size_t WS_WFF2 = WS_WFF1 + (size_t)DEPTH * DFF * D * 2;
constexpr size_t WS_X = WS_WFF2 + (size_t)DEPTH * DFF * D * 2;
constexpr size_t WS_H = WS_X + (size_t)MP * D * 4;
constexpr size_t WS_AIN = WS_H + (size_t)MP * D * 2;
constexpr size_t WS_Z = WS_AIN + (size_t)MP * 16 * 4;
constexpr size_t WS_ZS5 = WS_Z + (size_t)MP * ZW * 2;
constexpr size_t WS_Y = WS_ZS5 + (size_t)MP * 1024 * 2;
constexpr size_t WS_GLAO = WS_Y + (size_t)3 * MP * 1024 * 2;
constexpr size_t WS_DEC = WS_GLAO + (size_t)MP * 1024 * 4;
constexpr size_t WS_MRG = WS_DEC + (size_t)MP * 512 * 4;
constexpr size_t WS_MERGED = WS_MRG + (size_t)MP * D * 4;
constexpr size_t WS_MIX = WS_MERGED + (size_t)MP * D * 2;
constexpr size_t WS_S5A = WS_MIX + (size_t)MP * D * 4;
constexpr size_t WS_S5B = WS_S5A + (size_t)DEPTH * 4096 * 2 * 4;
constexpr size_t WS_BIAS = WS_S5B + (size_t)DEPTH * 4096 * 32 * 4;
constexpr size_t WS_END = WS_BIAS + 16 * 128 * 4;

__device__ __forceinline__ unsigned cvt_pk_bf16(float lo, float hi) { unsigned r; asm volatile("v_cvt_pk_bf16_f32 %0, %1, %2" : "=v"(r) : "v"(lo), "v"(hi)); return r; }
__device__ __forceinline__ bf16_t f2bf(float f) { return (bf16_t)(cvt_pk_bf16(f, 0.f) & 0xffffu); }
__device__ __forceinline__ float bf2f(bf16_t b) { return __uint_as_float(((unsigned)b) << 16); }
__device__ __forceinline__ float bflo(unsigned u) { return __uint_as_float(u << 16); }
__device__ __forceinline__ float bfhi(unsigned u) { return __uint_as_float(u & 0xffff0000u); }
__device__ __forceinline__ float wave_sum(float v) {
#pragma unroll
    for (int o = 32; o >= 1; o >>= 1) v += __shfl_xor(v, o);
    return v; }
__device__ __forceinline__ float wave_max(float v) {
#pragma unroll
    for (int o = 32; o >= 1; o >>= 1) v = fmaxf(v, __shfl_xor(v, o));
    return v; }
__device__ __forceinline__ float sigmoidf_(float x) { return 1.0f / (1.0f + __expf(-x)); }
__device__ __forceinline__ float gelu_tanh(float y) { const float a = 0.7978845608028654f * (y + 0.044715f * y * y * y); const float e = __expf(2.0f * a); const float th = 1.0f - 2.0f / (e + 1.0f); return 0.5f * y * (1.0f + th); }

#define XB_TMO      128
#define XB_XCNT(j)  (256  + 64 * (j))
#define XB_XSUB(j)  (1280 + 64 * (j))
#define XB_XGEN(j)  (2304 + 64 * (j))
#define XB_TOP      3328
#define XB_TOPGEN   3392
#define XCD_BAR_WORDS 3456
#define XB_SPIN_CAP (1u << 18)

__device__ __forceinline__ unsigned xb_ld(unsigned* p)              { return __hip_atomic_load(p, __ATOMIC_RELAXED, __HIP_MEMORY_SCOPE_AGENT); }
__device__ __forceinline__ unsigned xb_add(unsigned* p, unsigned v) { return __hip_atomic_fetch_add(p, v, __ATOMIC_RELAXED, __HIP_MEMORY_SCOPE_AGENT); }
__device__ __forceinline__ unsigned xb_xcc_id() { return (unsigned)__builtin_amdgcn_s_getreg((3 << 11) | 20) & 0xFu; }
#define XB_SPIN(cond, bar) do { unsigned _sp = 0; while (cond) { __builtin_amdgcn_s_sleep(1); \
    if ((++_sp & 255u) == 0u) { if (xb_ld(&(bar)[XB_TMO])) break; if (_sp > XB_SPIN_CAP) { atomicAdd(&(bar)[XB_TMO], 1u); break; } } } } while (0)

struct XcdBarrier {
    unsigned* bar; unsigned x;
    volatile LAS unsigned* st;
};

__device__ __forceinline__ XcdBarrier xcd_barrier_post(unsigned* bar, volatile LAS unsigned* st) {
    XcdBarrier b; b.bar = bar; b.x = xb_xcc_id(); b.st = st;
    if (threadIdx.x == 0) (void)xb_add(&bar[XB_XCNT(b.x)], 1u);
    return b;
}
__device__ __forceinline__ void xcd_barrier_complete(unsigned* bar, unsigned x, unsigned& nloc, unsigned& nx) {
    const unsigned G = gridDim.x * gridDim.y * gridDim.z;
    unsigned sum, cnt, mine, sp = 0u;
    for (;;) {
        sum = 0u; cnt = 0u; mine = 0u;
#pragma unroll
        for (unsigned j = 0; j < 16; ++j) { const unsigned c = xb_ld(&bar[XB_XCNT(j)]); sum += c; cnt += (c > 0u) ? 1u : 0u; mine = (j == x) ? c : mine; }
        if (sum == G) break;
        __builtin_amdgcn_s_sleep(1);
        if ((++sp & 255u) == 0u) { if (xb_ld(&bar[XB_TMO])) break; if (sp > XB_SPIN_CAP) { atomicAdd(&bar[XB_TMO], 1u); break; } }
    }
    nloc = mine > 0u ? mine : 1u; nx = cnt > 0u ? cnt : 1u;
}

__device__ __forceinline__ void xcd_barrier(const XcdBarrier& b) {
    asm volatile("s_waitcnt vmcnt(0)" ::: "memory");
    __syncthreads();
    if (threadIdx.x == 0) {
        unsigned* bar = b.bar;
        __builtin_amdgcn_s_waitcnt(0);
        unsigned nloc = b.st[0], nx = b.st[1];
        if (nloc == 0u) { xcd_barrier_complete(bar, b.x, nloc, nx); b.st[0] = nloc; b.st[1] = nx; }
        const unsigned old = xb_add(&bar[XB_XSUB(b.x)], 1u);
        const unsigned gen = old / nloc;
        if (old + 1u == (gen + 1u) * nloc) {
            __builtin_amdgcn_fence(__ATOMIC_RELEASE, "agent");
            asm volatile("s_waitcnt vmcnt(0)" ::: "memory");
            const unsigned og = xb_add(&bar[XB_TOP], 1u);
            const unsigned tg = og / nx;
            if (og + 1u == (tg + 1u) * nx) xb_add(&bar[XB_TOPGEN], 1u);
            else XB_SPIN(xb_ld(&bar[XB_TOPGEN]) == tg, bar);
            __builtin_amdgcn_fence(__ATOMIC_ACQUIRE, "agent");
            xb_add(&bar[XB_XGEN(b.x)], 1u);
            asm volatile("s_waitcnt vmcnt(0)" ::: "memory");
        } else {
            XB_SPIN(xb_ld(&bar[XB_XGEN(b.x)]) == gen, bar);
            __builtin_amdgcn_fence(__ATOMIC_ACQUIRE, "agent");
            asm volatile("s_waitcnt vmcnt(0)" ::: "memory");
        }
    }
    __syncthreads();
}

namespace pg8 {
#define PG8_LAS __attribute__((address_space(3)))
typedef unsigned short bf16_t;
typedef short bf16x8 __attribute__((ext_vector_type(8)));
typedef float f32x4 __attribute__((ext_vector_type(4)));
typedef unsigned u32x4 __attribute__((ext_vector_type(4)));
constexpr int BM = 256, BK = 64, HALF = 128, HTB = HALF * BK * 2  , STAGE_BYTES = 8 * HTB, NXCD = 8, WGM = 8;

__host__ __device__ __forceinline__ int lds_byte(int r, int c) { const int st = (r >> 4) * 2 + (c >> 5), rr = r & 15, cc = c & 31, ob = rr * 64 + cc * 2; return st * 1024 + (ob ^ (((ob >> 9) & 1) << 5)); }
__host__ __device__ __forceinline__ void stage_rc(int b, int& R, int& C) { const int st = b / 1024, sb = b % 1024, swz = sb ^ (((sb >> 9) & 1) << 5); R = (st >> 1) * 16 + swz / 64; C = (st & 1) * 32 + (swz % 64) / 2; }
__host__ __device__ __forceinline__ int perm32(int rho) { const int n = rho >> 4, i = rho & 15; return 8 * (i >> 2) + 4 * n + (i & 3); }

struct Unit { int pm, pn; };
struct Gemm { const bf16_t* A; const bf16_t* Bt; int M, N, K; };

struct StaticOrder {
    int nM, nN, nwg, G, c;
    __host__ __device__ void init(int M, int N, int G_, int c_) { nM = M / BM; nN = N / BM; nwg = nM * nN; G = G_; c = c_; }
    __host__ __device__ bool next(int i, Unit& u) const {
        const long L = (long)i * G + c; if (L >= nwg) return false;
        int wgid = (int)L; { const int q = nwg / NXCD, r = nwg % NXCD, xcd = wgid % NXCD, off = wgid / NXCD; wgid = (xcd < r ? xcd * (q + 1) : r * (q + 1) + (xcd - r) * q) + off; }
        const int nig = WGM * nN, gid = wgid / nig, fm = gid * WGM, gsz = (nM - fm) < WGM ? (nM - fm) : WGM;
        u.pm = fm + ((wgid % nig) % gsz); u.pn = (wgid % nig) / gsz; return true;
    }
    __device__ __forceinline__ void a_ready(const Unit&) const {}
    __device__ __forceinline__ void done(const Unit&) const {}
};

__device__ __forceinline__ unsigned cvt_pk_bf16(float lo, float hi) { unsigned r; asm volatile("v_cvt_pk_bf16_f32 %0, %1, %2" : "=v"(r) : "v"(lo), "v"(hi)); return r; }
__device__ __forceinline__ float sigm(float x) { return 1.0f / (1.0f + __expf(-x)); }

struct EpiF32 {
    static constexpr bool PERM = false, AFTER_DRAIN = false;
    float* C; int ldc;
    __device__ __forceinline__ void operator()(const f32x4 (&acc)[2][2][4][2], const Unit& u, int wr, int wc, int fr, int fq) const {
        const int row0 = u.pm * BM + wr * 64 + fr, col0 = u.pn * BM + wc * 32 + 4 * fq;
#pragma unroll
        for (int ai = 0; ai < 2; ++ai)
#pragma unroll
            for (int m = 0; m < 4; ++m) { float* rowp = C + (size_t)(row0 + ai * HALF + m * 16) * ldc + col0;
#pragma unroll
                for (int bj = 0; bj < 2; ++bj)
#pragma unroll
                    for (int n = 0; n < 2; ++n) *(f32x4*)(rowp + bj * HALF + n * 16) = acc[ai][bj][m][n]; }
    }
};
struct EpiIn {
    static constexpr bool PERM = true, AFTER_DRAIN = false;
    bf16_t* O; int ldc;
    __device__ __forceinline__ void operator()(const f32x4 (&acc)[2][2][4][2], const Unit& u, int wr, int wc, int fr, int fq) const {
        const int row0 = u.pm * BM + wr * 64 + fr, col0 = u.pn * BM + wc * 32 + 8 * fq;
        const int pn = u.pn;
        const int act = (pn >= 22) ? 1 : ((pn >= 12 && pn < 16) ? 2 : ((pn == 4 || pn == 5 || (pn >= 16 && pn < 20)) ? 3 : 0));
        const float sc = (pn == 4 || pn == 5) ? 0.08838834764831845f : 0.125f;
#pragma unroll
        for (int ai = 0; ai < 2; ++ai)
#pragma unroll
            for (int m = 0; m < 4; ++m) { bf16_t* rowp = O + (size_t)(row0 + ai * HALF + m * 16) * ldc + col0;
#pragma unroll
                for (int bj = 0; bj < 2; ++bj) { f32x4 v0 = acc[ai][bj][m][0], v1 = acc[ai][bj][m][1];
                    if (act == 1) {
#pragma unroll
                        for (int j = 0; j < 4; ++j) { v0[j] = sigm(v0[j]); v1[j] = sigm(v1[j]); } }
                    else if (act == 2) {
#pragma unroll
                        for (int j = 0; j < 4; ++j) { v0[j] = v0[j] * sigm(v0[j]); v1[j] = v1[j] * sigm(v1[j]); } }
                    else if (act == 3) { v0 = v0 * sc; v1 = v1 * sc; }
                    u32x4 w; w.x = cvt_pk_bf16(v0[0], v0[1]); w.y = cvt_pk_bf16(v0[2], v0[3]); w.z = cvt_pk_bf16(v1[0], v1[1]); w.w = cvt_pk_bf16(v1[2], v1[3]);
                    *(u32x4*)(rowp + bj * HALF) = w; } }
    }
};
struct EpiFF1 {
    static constexpr bool PERM = true, AFTER_DRAIN = false;
    bf16_t* O; int ldc;
    __device__ __forceinline__ void operator()(const f32x4 (&acc)[2][2][4][2], const Unit& u, int wr, int wc, int fr, int fq) const {
        const int row0 = u.pm * BM + wr * 64 + fr, col0 = u.pn * BM + wc * 32 + 8 * fq;
#pragma unroll
        for (int ai = 0; ai < 2; ++ai)
#pragma unroll
            for (int m = 0; m < 4; ++m) { bf16_t* rowp = O + (size_t)(row0 + ai * HALF + m * 16) * ldc + col0;
#pragma unroll
                for (int bj = 0; bj < 2; ++bj) { f32x4 v0 = acc[ai][bj][m][0], v1 = acc[ai][bj][m][1];
#pragma unroll
                    for (int j = 0; j < 4; ++j) { const float a = fmaxf(v0[j], 0.f), b = fmaxf(v1[j], 0.f); v0[j] = a * a; v1[j] = b * b; }
                    u32x4 w; w.x = cvt_pk_bf16(v0[0], v0[1]); w.y = cvt_pk_bf16(v0[2], v0[3]); w.z = cvt_pk_bf16(v1[0], v1[1]); w.w = cvt_pk_bf16(v1[2], v1[3]);
                    *(u32x4*)(rowp + bj * HALF) = w; } }
    }
};
struct EpiGlu {
    static constexpr bool PERM = true, AFTER_DRAIN = false;
    bf16_t* O; const bf16_t* Zs; const float* bias; int ldc;
    __device__ __forceinline__ void operator()(const f32x4 (&acc)[2][2][4][2], const Unit& u, int wr, int wc, int fr, int fq) const {
        const int row0 = u.pm * BM + wr * 64 + fr, col0 = u.pn * BM + wc * 32 + 8 * fq;
        f32x4 bv[2][2];
#pragma unroll
        for (int bj = 0; bj < 2; ++bj)
#pragma unroll
            for (int n = 0; n < 2; ++n) bv[bj][n] = *(const f32x4*)(bias + col0 + bj * HALF + 4 * n);
#pragma unroll
        for (int ai = 0; ai < 2; ++ai)
#pragma unroll
            for (int m = 0; m < 4; ++m) { const size_t ro = (size_t)(row0 + ai * HALF + m * 16) * ldc + col0;
#pragma unroll
                for (int bj = 0; bj < 2; ++bj) { f32x4 v0 = acc[ai][bj][m][0] + bv[bj][0], v1 = acc[ai][bj][m][1] + bv[bj][1];
                    const u32x4 zz = *(const u32x4*)(Zs + ro + bj * HALF);
                    const float z0 = __uint_as_float(zz.x << 16), z1 = __uint_as_float(zz.x & 0xffff0000u), z2 = __uint_as_float(zz.y << 16), z3 = __uint_as_float(zz.y & 0xffff0000u);
                    const float z4 = __uint_as_float(zz.z << 16), z5 = __uint_as_float(zz.z & 0xffff0000u), z6 = __uint_as_float(zz.w << 16), z7 = __uint_as_float(zz.w & 0xffff0000u);
                    u32x4 w; w.x = cvt_pk_bf16(z0 * sigm(v0[0]), z1 * sigm(v0[1])); w.y = cvt_pk_bf16(z2 * sigm(v0[2]), z3 * sigm(v0[3]));
                    w.z = cvt_pk_bf16(z4 * sigm(v1[0]), z5 * sigm(v1[1])); w.w = cvt_pk_bf16(z6 * sigm(v1[2]), z7 * sigm(v1[3]));
                    *(u32x4*)(O + ro + bj * HALF) = w; } }
    }
};
template <int KB> struct EpiMerge {
    static constexpr bool PERM = false, AFTER_DRAIN = false;
    float* mrg; bf16_t* out; const bf16_t* gate; int ldg;
    __device__ __forceinline__ void operator()(const f32x4 (&acc)[2][2][4][2], const Unit& u, int wr, int wc, int fr, int fq) const {
        const int row0 = u.pm * BM + wr * 64 + fr, col0 = u.pn * BM + wc * 32 + 4 * fq;
#pragma unroll
        for (int ai = 0; ai < 2; ++ai)
#pragma unroll
            for (int m = 0; m < 4; ++m) { const size_t r = (size_t)(row0 + ai * HALF + m * 16);
#pragma unroll
                for (int bj = 0; bj < 2; ++bj)
#pragma unroll
                    for (int n = 0; n < 2; ++n) { const int c = col0 + bj * HALF + n * 16;
                        const u32x2 gg = *(const u32x2*)(gate + r * ldg + c);
                        f32x4 gv; gv[0] = __uint_as_float(gg.x << 16); gv[1] = __uint_as_float(gg.x & 0xffff0000u); gv[2] = __uint_as_float(gg.y << 16); gv[3] = __uint_as_float(gg.y & 0xffff0000u);
                        f32x4 v = gv * acc[ai][bj][m][n];
                        if (KB >= 1) v = v + *(const f32x4*)(mrg + r * 2048 + c);
                        if (KB <= 1) *(f32x4*)(mrg + r * 2048 + c) = v;
                        else { u32x2 w; w.x = cvt_pk_bf16(v[0], v[1]); w.y = cvt_pk_bf16(v[2], v[3]); *(u32x2*)(out + r * 2048 + c) = w; } }
                asm volatile("" ::: "memory"); }
    }
};

template <class Epi, class Sched, bool STAMP = false>
__device__ __forceinline__ void gemm_phase(PG8_LAS unsigned char* lds, const Gemm g, const Sched& S, const Epi& E, unsigned long long* stamps) {
    int tid_ = threadIdx.x; asm volatile("" : "+v"(tid_)); const int tid = tid_, wid = __builtin_amdgcn_readfirstlane(tid >> 6), lane = tid & 63, wr = wid >> 2, wc = wid & 3, fr = lane & 15, fq = lane >> 4;
    const int K = g.K, nt = K / BK;
    int ts_lo = 0, ts_hi = 0, nts = 0; const unsigned long long rt_entry = STAMP ? (unsigned long long)wall_clock64() : 0ull;
#define PG8_STAMP() do { if (STAMP && wid == 0 && nts < 64) { const unsigned long long _c = (unsigned long long)clock64(); \
        ts_lo = (lane == nts) ? (int)(unsigned)_c : ts_lo; ts_hi = (lane == nts) ? (int)(unsigned)(_c >> 32) : ts_hi; ++nts; } } while (0)
    PG8_STAMP();
    unsigned voffA[2], voffB[2];
#pragma unroll
    for (int i = 0; i < 2; ++i) { int R, C; stage_rc(tid * 16 + i * 8192, R, C); const int Rb = Epi::PERM ? ((R & ~31) + perm32(R & 31)) : R;
        voffA[i] = (unsigned)(R * K + C) * 2u; voffB[i] = (unsigned)(Rb * K + C) * 2u; }
    const size_t kstep = (size_t)(BK * 2);
    const size_t hstep = (size_t)HALF * K * 2;
    const size_t tstep = 2 * hstep;
    const unsigned ldsw = (unsigned)wid * 1024u;
    const int aoff = lds_byte(wr * 64 + fr, fq * 8), boff = lds_byte(wc * 32 + fr, fq * 8);
#define PG8_SA(b, h) (((b) * 2 + (h)) * HTB)
#define PG8_SB(b, h) ((4 + (b) * 2 + (h)) * HTB)
#define PG8_STAGE(bufoff, gbase, voff) do { _Pragma("unroll") for (int _i = 0; _i < 2; ++_i) \
        __builtin_amdgcn_global_load_lds((const unsigned*)((const char*)(gbase) + (voff)[_i]), (PG8_LAS unsigned*)(lds + (bufoff) + ldsw + _i * 8192), 16, 0, 0); } while (0)
#define PG8_LDA(dst, b, h) do { _Pragma("unroll") for (int m = 0; m < 4; ++m) _Pragma("unroll") for (int k = 0; k < 2; ++k) dst[m][k] = *(const PG8_LAS bf16x8*)(lds + PG8_SA(b, h) + aoff + m * 2048 + k * 1024); } while (0)
#define PG8_LDB(dst, b, h) do { _Pragma("unroll") for (int n = 0; n < 2; ++n) _Pragma("unroll") for (int k = 0; k < 2; ++k) dst[n][k] = *(const PG8_LAS bf16x8*)(lds + PG8_SB(b, h) + boff + n * 2048 + k * 1024); } while (0)
#define PG8_MMA(ai, bj, At, Bt) do { __builtin_amdgcn_s_setprio(1); _Pragma("unroll") for (int m = 0; m < 4; ++m) _Pragma("unroll") for (int n = 0; n < 2; ++n) _Pragma("unroll") for (int k = 0; k < 2; ++k) \
        acc[ai][bj][m][n] = __builtin_amdgcn_mfma_f32_16x16x32_bf16(Bt[n][k], At[m][k], acc[ai][bj][m][n], 0, 0, 0); __builtin_amdgcn_s_setprio(0); } while (0)
#define PG8_WAIT_V(n) asm volatile("s_waitcnt vmcnt(" #n ")" ::: "memory")
#define PG8_WAIT_L(n) asm volatile("s_waitcnt lgkmcnt(" #n ")" ::: "memory")
#define PG8_BAR __builtin_amdgcn_s_barrier()
#define PG8_SCHED __builtin_amdgcn_sched_barrier(0)
    Unit cur, nxt; int ui = 0;
    if (!S.next(0, cur)) return;
    f32x4 acc[2][2][4][2];
#pragma unroll
    for (int a = 0; a < 2; ++a)
#pragma unroll
        for (int b = 0; b < 2; ++b)
#pragma unroll
            for (int m = 0; m < 4; ++m)
#pragma unroll
                for (int n = 0; n < 2; ++n) acc[a][b][m][n] = (f32x4){0.f, 0.f, 0.f, 0.f};
    bf16x8 At[4][2], B0[2][2], B1[2][2];
    const char* cA = (const char*)g.A + (size_t)cur.pm * tstep; const char* cB = (const char*)g.Bt + (size_t)cur.pn * tstep;
    S.a_ready(cur);
    PG8_STAGE(PG8_SB(0, 0), cB, voffB); PG8_STAGE(PG8_SA(0, 0), cA, voffA); PG8_STAGE(PG8_SB(0, 1), cB + hstep, voffB); PG8_STAGE(PG8_SA(0, 1), cA + hstep, voffA);
    if (wr == 1) PG8_BAR;
    PG8_WAIT_V(4); PG8_BAR;
    PG8_STAGE(PG8_SB(1, 0), cB + kstep, voffB); PG8_STAGE(PG8_SA(1, 0), cA + kstep, voffA); PG8_STAGE(PG8_SB(1, 1), cB + hstep + kstep, voffB);
    PG8_WAIT_V(6); PG8_BAR;
    PG8_STAMP();
    for (;;) {
        const bool has_next = S.next(ui + 1, nxt);
        const char* nA = has_next ? (const char*)g.A + (size_t)nxt.pm * tstep : cA; const char* nB = has_next ? (const char*)g.Bt + (size_t)nxt.pn * tstep : cB;
        for (int t = 0; t < nt; t += 2) {
            const bool last = (t == nt - 2);
            const char* a1 = cA + (size_t)(t + 1) * kstep;
            const char* a2 = last ? nA : cA + (size_t)(t + 2) * kstep; const char* b2 = last ? nB : cB + (size_t)(t + 2) * kstep;
            const char* a3 = a2 + kstep; const char* b3 = b2 + kstep;
            if (last && has_next) S.a_ready(nxt);
            PG8_LDB(B0, 0, 0); PG8_SCHED; PG8_LDA(At, 0, 0); PG8_STAGE(PG8_SA(1, 1), a1 + hstep, voffA);
            PG8_WAIT_L(8); PG8_BAR; PG8_WAIT_L(0); PG8_MMA(0, 0, At, B0); PG8_BAR; PG8_SCHED;
            PG8_LDB(B1, 0, 1); PG8_STAGE(PG8_SB(0, 0), b2, voffB);
            PG8_BAR; PG8_WAIT_L(0); PG8_MMA(0, 1, At, B1); PG8_BAR;
            PG8_LDA(At, 0, 1); PG8_STAGE(PG8_SA(0, 0), a2, voffA);
            PG8_BAR; PG8_WAIT_L(0); PG8_MMA(1, 0, At, B0); PG8_BAR; PG8_SCHED;
            PG8_STAGE(PG8_SB(0, 1), b2 + hstep, voffB);
            PG8_WAIT_V(6); PG8_BAR; PG8_MMA(1, 1, At, B1); PG8_BAR;
            PG8_LDB(B0, 1, 0); PG8_SCHED; PG8_LDA(At, 1, 0); PG8_STAGE(PG8_SA(0, 1), a2 + hstep, voffA);
            PG8_WAIT_L(8); PG8_BAR; PG8_WAIT_L(0); PG8_MMA(0, 0, At, B0); PG8_BAR; PG8_SCHED;
            PG8_LDB(B1, 1, 1); PG8_STAGE(PG8_SB(1, 0), b3, voffB);
            PG8_BAR; PG8_WAIT_L(0); PG8_MMA(0, 1, At, B1); PG8_BAR;
            PG8_LDA(At, 1, 1); PG8_STAGE(PG8_SA(1, 0), a3, voffA);
            PG8_BAR; PG8_WAIT_L(0); PG8_MMA(1, 0, At, B0); PG8_BAR; PG8_SCHED;
            PG8_STAGE(PG8_SB(1, 1), b3 + hstep, voffB);
            PG8_WAIT_V(6); PG8_BAR; PG8_MMA(1, 1, At, B1); PG8_BAR;
        }
        PG8_STAMP();
        if constexpr (!Epi::AFTER_DRAIN) { E(acc, cur, wr, wc, fr, fq); S.done(cur); }
        PG8_STAMP();
        if (!has_next) break;
#pragma unroll
        for (int a = 0; a < 2; ++a)
#pragma unroll
            for (int b = 0; b < 2; ++b)
#pragma unroll
                for (int m = 0; m < 4; ++m)
#pragma unroll
                    for (int n = 0; n < 2; ++n) acc[a][b][m][n] = (f32x4){0.f, 0.f, 0.f, 0.f};
        cur = nxt; cA = nA; cB = nB; ++ui;
    }
    PG8_WAIT_V(0);
    if (wr == 0) PG8_BAR;
    PG8_BAR;
    if constexpr (Epi::AFTER_DRAIN) { E.fused(acc, cur, wr, wc, fr, fq, lds, wid, lane); S.done(cur); }
    PG8_STAMP();
    if (STAMP && wid == 0) { stamps[lane] = lane < nts ? (((unsigned long long)(unsigned)ts_hi << 32) | (unsigned)ts_lo) : 0ull;
        if (lane == 62) stamps[62] = rt_entry; if (lane == 63) stamps[63] = (unsigned long long)wall_clock64(); }
#undef PG8_STAMP
#undef PG8_SA
#undef PG8_SB
#undef PG8_STAGE
#undef PG8_LDA
#undef PG8_LDB
#undef PG8_MMA
#undef PG8_WAIT_V
#undef PG8_WAIT_L
#undef PG8_BAR
#undef PG8_SCHED
}
}

constexpr int NTHR = 512, NWAVE = 8;
constexpr int LDS_STAGE = 131072, LDS_MISC_OFF = LDS_STAGE, LDS_BYTES = LDS_STAGE + 4096;

struct Args { const float* in[N_IN]; float* out; unsigned char* ws; int ph_lo, ph_hi; };

struct Frame {
    const float* const* in; float* out; unsigned char* ws; LAS unsigned char* lds;
    int tid, lane, wave, G, bid;
    __device__ __forceinline__ void fresh() { int t = threadIdx.x; asm volatile("" : "+v"(t)); tid = t; lane = t & 63; wave = __builtin_amdgcn_readfirstlane(t >> 6); int b = blockIdx.x; asm volatile("" : "+s"(b)); bid = b; }
    bf16_t *Wt_in, *Wt_glu, *Wt_up, *Wt_out, *Wt_ff1, *Wt_ff2;
    float* X; bf16_t* H; float* AIN; bf16_t* Z; bf16_t* ZS5; bf16_t* Y; float* GLAO; float* DEC; float* MRG; bf16_t* MERGED; float* MIX; bf16_t* FFH;
    float* S5A; float* S5B; float* BIAS;
};

__device__ __forceinline__ void transpose_convert(const Frame& F, const float* __restrict__ src, bf16_t* __restrict__ dst, int K, int ld, int N, bool is_in) {
    const int ntn = N / 64, ntiles = ntn * (K / 64);
    for (int tile = F.bid * NWAVE + F.wave; tile < ntiles; tile += F.G * NWAVE) {
        const int kt = tile / ntn, nt = tile - kt * ntn, n0 = nt * 64, k0 = kt * 64;
        int sc = n0 + F.lane; if (is_in && sc >= 3072) sc += 16;
        const float* sp = src + (size_t)k0 * ld + sc;
        float v[64];
#pragma unroll
        for (int i = 0; i < 64; ++i) v[i] = sp[(size_t)i * ld];
        u32x4* dp = (u32x4*)(dst + (size_t)(n0 + F.lane) * K + k0);
#pragma unroll
        for (int j = 0; j < 8; ++j) { u32x4 w; w.x = cvt_pk_bf16(v[8 * j], v[8 * j + 1]); w.y = cvt_pk_bf16(v[8 * j + 2], v[8 * j + 3]); w.z = cvt_pk_bf16(v[8 * j + 4], v[8 * j + 5]); w.w = cvt_pk_bf16(v[8 * j + 6], v[8 * j + 7]); dp[j] = w; }
    }
}
__device__ __forceinline__ void prologue_phase(const Frame& F) {
    for (int l = 0; l < DEPTH; ++l) {
        transpose_convert(F, F.in[I_WIN] + (size_t)l * D * INW, F.Wt_in + (size_t)l * ZW * D, D, INW, ZW, true);
        transpose_convert(F, F.in[I_WGLU] + (size_t)l * 1024 * 1024, F.Wt_glu + (size_t)l * 1024 * 1024, 1024, 1024, 1024, false);
        transpose_convert(F, F.in[I_WUS5] + (size_t)l * 1024 * D, F.Wt_up + ((size_t)l * 3 + 0) * D * 1024, 1024, D, D, false);
        transpose_convert(F, F.in[I_WUGLA] + (size_t)l * 1024 * D, F.Wt_up + ((size_t)l * 3 + 1) * D * 1024, 1024, D, D, false);
        transpose_convert(F, F.in[I_WUSWA] + (size_t)l * 1024 * D, F.Wt_up + ((size_t)l * 3 + 2) * D * 1024, 1024, D, D, false);
        transpose_convert(F, F.in[I_WOUT] + (size_t)l * D * D, F.Wt_out + (size_t)l * D * D, D, D, D, false);
        transpose_convert(F, F.in[I_WFF1] + (size_t)l * D * DFF, F.Wt_ff1 + (size_t)l * DFF * D, D, DFF, DFF, false);
        transpose_convert(F, F.in[I_WFF2] + (size_t)l * DFF * D, F.Wt_ff2 + (size_t)l * D * DFF, DFF, D, D, false);
    }
    for (int idx = F.bid * NTHR + F.tid; idx < DEPTH * 4096; idx += F.G * NTHR) {
        const int l = idx >> 12, g = (idx >> 6) & 63;
        const double dt = exp((double)F.in[I_LSTEP][l * 64 + g]);
        const double lr = (double)F.in[I_LRE][idx], li = (double)F.in[I_LIM][idx];
        const double mag = exp(lr * dt), ar = mag * cos(li * dt), ai = mag * sin(li * dt);
        const double den = lr * lr + li * li;
        const double fr = ((ar - 1.0) * lr + ai * li) / den, fi = (ai * lr - (ar - 1.0) * li) / den;
        F.S5A[idx * 2 + 0] = (float)ar; F.S5A[idx * 2 + 1] = (float)ai;
        const float* br = F.in[I_BRE] + (size_t)idx * 16; const float* bi = F.in[I_BIM] + (size_t)idx * 16;
        float* o = F.S5B + (size_t)idx * 32;
#pragma unroll
        for (int h = 0; h < 16; ++h) { const double b_r = br[h], b_i = bi[h]; o[h] = (float)(fr * b_r - fi * b_i); o[16 + h] = (float)(fr * b_i + fi * b_r); }
    }
    for (int idx = F.bid * NTHR + F.tid; idx < 16 * 128; idx += F.G * NTHR) {
        const int hq = idx >> 7, d = idx & 127;
        int bucket = d;
        if (d >= 16) { bucket = 16 + (int)(log((double)d / 16.0) / log(8.0) * 16.0); if (bucket > 31) bucket = 31; }
        F.BIAS[idx] = F.in[I_RELB][bucket * 16 + hq];
    }
}

template <int MODE>
__device__ __forceinline__ void norm_phase(const Frame& F, int l) {
    constexpr bool AIN = (MODE == 0 || MODE == 2);
    const float* gA = (MODE == 1) ? F.in[I_NQM] + l * D : (MODE == 2) ? F.in[I_NQF] + (l - 1) * D : F.in[I_NQF] + 3 * D;
    const float* gB = (MODE == 0) ? F.in[I_NPM] : (MODE == 1) ? F.in[I_NPF] + l * D : F.in[I_NPM] + l * D;
    LAS f32x4* WaL = (LAS f32x4*)F.lds;
    if (AIN) {
        const float* wl = F.in[I_WIN] + (size_t)l * D * INW + 3072;
        for (int idx = F.tid; idx < 2048 * 4; idx += NTHR) { const int k = idx >> 2, nq = idx & 3;
            const f32x4 w = *(const f32x4*)(wl + (size_t)k * INW + nq * 4);
            const int kk = k >> 8, ln = (k & 255) >> 2, j = k & 3;
            WaL[((kk * 4 + j) * 4 + nq) * 64 + ln] = w; }
        __syncthreads();
    }
    for (int row = F.bid * NWAVE + F.wave; row < MP; row += F.G * NWAVE) {
        if (row >= MREAL) {
            if (MODE == 0) { const f32x4 z4 = {0.f, 0.f, 0.f, 0.f}; const u32x2 z2 = {0u, 0u};
#pragma unroll
                for (int kk = 0; kk < 8; ++kk) { ((f32x4*)(F.X + (size_t)row * D))[kk * 64 + F.lane] = z4; ((u32x2*)(F.H + (size_t)row * D))[kk * 64 + F.lane] = z2; }
                if (F.lane < 16) F.AIN[row * 16 + F.lane] = 0.f; }
            continue;
        }
        f32x4 xv[8];
        const f32x4* xs;
        if (MODE == 0) {
            if (row < ROWS_P) { const int b = row / TP, t = row - b * TP; xs = (t < NMETA) ? (const f32x4*)(F.in[I_META] + (size_t)t * D) : (const f32x4*)(F.in[I_XP] + ((size_t)b * SEQ + (t - NMETA)) * D); }
            else xs = (const f32x4*)(F.in[I_XS] + (size_t)(row - ROWS_P) * D);
        } else xs = (const f32x4*)(F.X + (size_t)row * D);
#pragma unroll
        for (int kk = 0; kk < 8; ++kk) xv[kk] = xs[kk * 64 + F.lane];
        if (MODE != 0) {
            const f32x4* rs_ = (const f32x4*)(F.MIX + (size_t)row * D);
            f32x4 rv[8]; float ss = 0.f;
#pragma unroll
            for (int kk = 0; kk < 8; ++kk) { rv[kk] = rs_[kk * 64 + F.lane]; ss += rv[kk][0] * rv[kk][0] + rv[kk][1] * rv[kk][1] + rv[kk][2] * rv[kk][2] + rv[kk][3] * rv[kk][3]; }
            ss = wave_sum(ss);
            const float rs = 1.0f / sqrtf(ss * (1.0f / D) + EPS);
#pragma unroll
            for (int kk = 0; kk < 8; ++kk) { const f32x4 ga = ((const f32x4*)gA)[kk * 64 + F.lane]; xv[kk] = xv[kk] + rv[kk] * rs * ga; }
        }
        if (MODE == 3) {
            f32x4* od = nullptr;
            if (row < ROWS_P) { const int b = row / TP, t = row - b * TP; if (t >= NMETA) od = (f32x4*)(F.out + O_YP + ((size_t)b * SEQ + (t - NMETA)) * D); }
            else od = (f32x4*)(F.out + O_YS + (size_t)(row - ROWS_P) * D);
            if (od) {
#pragma unroll
                for (int kk = 0; kk < 8; ++kk) od[kk * 64 + F.lane] = xv[kk]; }
            continue;
        }
#pragma unroll
        for (int kk = 0; kk < 8; ++kk) ((f32x4*)(F.X + (size_t)row * D))[kk * 64 + F.lane] = xv[kk];
        float ss2 = 0.f;
#pragma unroll
        for (int kk = 0; kk < 8; ++kk) ss2 += xv[kk][0] * xv[kk][0] + xv[kk][1] * xv[kk][1] + xv[kk][2] * xv[kk][2] + xv[kk][3] * xv[kk][3];
        ss2 = wave_sum(ss2);
        const float rs2 = 1.0f / sqrtf(ss2 * (1.0f / D) + EPS);
#pragma unroll
        for (int kk = 0; kk < 8; ++kk) { const f32x4 gb = ((const f32x4*)gB)[kk * 64 + F.lane]; xv[kk] = xv[kk] * rs2 * gb;
            u32x2 w; w.x = cvt_pk_bf16(xv[kk][0], xv[kk][1]); w.y = cvt_pk_bf16(xv[kk][2], xv[kk][3]); ((u32x2*)(F.H + (size_t)row * D))[kk * 64 + F.lane] = w; }
        if (AIN) {
            float acc[16];
#pragma unroll
            for (int n = 0; n < 16; ++n) acc[n] = 0.f;
#pragma unroll
            for (int kk = 0; kk < 8; ++kk)
#pragma unroll
                for (int j = 0; j < 4; ++j) { const float hv = xv[kk][j];
#pragma unroll
                    for (int nq = 0; nq < 4; ++nq) { const f32x4 w = WaL[((kk * 4 + j) * 4 + nq) * 64 + F.lane];
                        acc[nq * 4 + 0] += hv * w[0]; acc[nq * 4 + 1] += hv * w[1]; acc[nq * 4 + 2] += hv * w[2]; acc[nq * 4 + 3] += hv * w[3]; } }
#pragma unroll
            for (int n = 0; n < 16; ++n) acc[n] = wave_sum(acc[n]);
            float mine = 0.f;
#pragma unroll
            for (int n = 0; n < 16; ++n) mine = (F.lane == n) ? acc[n] : mine;
            if (F.lane < 16) F.AIN[row * 16 + F.lane] = mine;
        }
    }
    if (AIN) __syncthreads();
}

__device__ __forceinline__ void gla_pre_phase(const Frame& F, int l) {
    const int t = F.tid & 127, sub = F.tid >> 7;
    const float* wg = F.in[I_WG2] + (size_t)l * 16 * 512 + 4 * t;
    f32x4 w[16];
#pragma unroll
    for (int r = 0; r < 16; ++r) w[r] = *(const f32x4*)(wg + r * 512);
    const f32x4 bg = *(const f32x4*)(F.in[I_BG2] + l * 512 + 4 * t);
    for (int row = F.bid * 4 + sub; row < MREAL; row += F.G * 4) {
        f32x4 a[4];
#pragma unroll
        for (int q = 0; q < 4; ++q) a[q] = *(const f32x4*)(F.AIN + row * 16 + q * 4);
        f32x4 pre = bg;
#pragma unroll
        for (int r = 0; r < 16; ++r) pre = pre + w[r] * a[r >> 2][r & 3];
        f32x4 o;
#pragma unroll
        for (int c = 0; c < 4; ++c) { const float x = pre[c]; const float ls = fminf(x, 0.f) - log1pf(expf(-fabsf(x))); o[c] = expf(ls * 0.0625f); }
        *(f32x4*)(F.DEC + (size_t)row * 512 + 4 * t) = o;
    }
}

__device__ __forceinline__ void s5_naive_phase(const Frame& F, int l) {
    LAS f32x2* sx = (LAS f32x2*)F.lds + F.wave * 64;
    const int p = F.lane, h = F.lane & 15, q = F.lane >> 4;
    for (int it = F.wave * F.G + F.bid; it < 36 * 64; it += F.G * NWAVE) {
        int g, T, row0, nseq; bool prompt;
        if (it < 256) { nseq = it >> 6; g = it & 63; T = TP; row0 = nseq * TP; prompt = true; }
        else { const int j = it - 256; nseq = j >> 6; g = j & 63; T = 1; row0 = ROWS_P + nseq; prompt = false; }
        const int gi = (l * 64 + g) * 64 + p;
        const float ar = F.S5A[gi * 2], ai = F.S5A[gi * 2 + 1];
        float bbr[16], bbi[16];
#pragma unroll
        for (int c = 0; c < 4; ++c) { const f32x4 a = *(const f32x4*)(F.S5B + (size_t)gi * 32 + c * 4), b = *(const f32x4*)(F.S5B + (size_t)gi * 32 + 16 + c * 4);
            bbr[c * 4] = a[0]; bbr[c * 4 + 1] = a[1]; bbr[c * 4 + 2] = a[2]; bbr[c * 4 + 3] = a[3]; bbi[c * 4] = b[0]; bbi[c * 4 + 1] = b[1]; bbi[c * 4 + 2] = b[2]; bbi[c * 4 + 3] = b[3]; }
        float cr[16], ci[16];
        { const float* crp = F.in[I_CRE] + ((size_t)(l * 64 + g) * 16 + h) * 64 + q * 16; const float* cip = F.in[I_CIM] + ((size_t)(l * 64 + g) * 16 + h) * 64 + q * 16;
#pragma unroll
            for (int c = 0; c < 4; ++c) { const f32x4 a = *(const f32x4*)(crp + c * 4), b = *(const f32x4*)(cip + c * 4);
                cr[c * 4] = a[0]; cr[c * 4 + 1] = a[1]; cr[c * 4 + 2] = a[2]; cr[c * 4 + 3] = a[3]; ci[c * 4] = b[0]; ci[c * 4 + 1] = b[1]; ci[c * 4 + 2] = b[2]; ci[c * 4 + 3] = b[3]; } }
        const float dsk = F.in[I_SD][l * 1024 + g * 16 + h];
        float xr = 0.f, xi = 0.f;
        if (!prompt) { xr = F.in[I_S5R][((size_t)(l * NDEC + nseq) * 64 + g) * 64 + p]; xi = F.in[I_S5I][((size_t)(l * NDEC + nseq) * 64 + g) * 64 + p]; }
        const bf16_t* up = F.Z + (size_t)row0 * ZW + ZU + g * 16;
        u32x4 u0 = *(const u32x4*)up, u1 = *(const u32x4*)(up + 8);
        for (int t = 0; t < T; ++t) {
            const u32x4 c0 = u0, c1 = u1;
            const float uh = bf2f(up[(size_t)t * ZW + h]);
            if (t + 1 < T) { u0 = *(const u32x4*)(up + (size_t)(t + 1) * ZW); u1 = *(const u32x4*)(up + (size_t)(t + 1) * ZW + 8); }
            float uu[16];
            uu[0] = bflo(c0.x); uu[1] = bfhi(c0.x); uu[2] = bflo(c0.y); uu[3] = bfhi(c0.y); uu[4] = bflo(c0.z); uu[5] = bfhi(c0.z); uu[6] = bflo(c0.w); uu[7] = bfhi(c0.w);
            uu[8] = bflo(c1.x); uu[9] = bfhi(c1.x); uu[10] = bflo(c1.y); uu[11] = bfhi(c1.y); uu[12] = bflo(c1.z); uu[13] = bfhi(c1.z); uu[14] = bflo(c1.w); uu[15] = bfhi(c1.w);
            float er = 0.f, ei = 0.f;
#pragma unroll
            for (int c = 0; c < 16; ++c) { er += bbr[c] * uu[c]; ei += bbi[c] * uu[c]; }
            const float nxr = ar * xr - ai * xi + er, nxi = ar * xi + ai * xr + ei;
            xr = nxr; xi = nxi;
            sx[p] = (f32x2){xr, xi};
            asm volatile("s_waitcnt lgkmcnt(0)" ::: "memory");
            float ys = 0.f;
#pragma unroll
            for (int c = 0; c < 16; ++c) { const f32x2 xv = sx[q * 16 + c]; ys += cr[c] * xv[0] - ci[c] * xv[1]; }
            asm volatile("s_waitcnt lgkmcnt(0)" ::: "memory");
            ys += __shfl_xor(ys, 16); ys += __shfl_xor(ys, 32);
            if (F.lane < 16) { const float y = ys + dsk * uh; F.ZS5[(size_t)(row0 + t) * 1024 + g * 16 + h] = f2bf(gelu_tanh(y)); }
        }
        if (prompt) { F.out[O_PS5R + ((size_t)(l * NB + nseq) * 64 + g) * 64 + p] = xr; F.out[O_PS5I + ((size_t)(l * NB + nseq) * 64 + g) * 64 + p] = xi; }
        else { F.out[O_SS5R + ((size_t)(l * NDEC + nseq) * 64 + g) * 64 + p] = xr; F.out[O_SS5I + ((size_t)(l * NDEC + nseq) * 64 + g) * 64 + p] = xi; }
    }
}

__device__ __forceinline__ void gla_naive_phase(const Frame& F, int l) {
    const int v = F.lane & 15, dq = F.lane >> 4;
    for (int it = F.wave * F.G + F.bid; it < 36 * 64; it += F.G * NWAVE) {
        int nseq, hd, dv, T, row0; bool prompt;
        if (it < 256) { nseq = it >> 6; hd = (it >> 4) & 3; dv = it & 15; T = TP; row0 = nseq * TP; prompt = true; }
        else { const int j = it - 256; nseq = j >> 6; hd = (j >> 4) & 3; dv = j & 15; T = 1; row0 = ROWS_P + nseq; prompt = false; }
        float S[32];
        float* sout = prompt ? F.out + O_PGLA + (((size_t)(l * NB + nseq) * 4 + hd) * 128 + dq * 32) * 256 + dv * 16 + v
                             : F.out + O_SGLA + (((size_t)(l * NDEC + nseq) * 4 + hd) * 128 + dq * 32) * 256 + dv * 16 + v;
        if (prompt) {
#pragma unroll
            for (int i = 0; i < 32; ++i) S[i] = 0.f; }
        else { const float* sin_ = F.in[I_GLA] + (((size_t)(l * NDEC + nseq) * 4 + hd) * 128 + dq * 32) * 256 + dv * 16 + v;
#pragma unroll
            for (int i = 0; i < 32; ++i) S[i] = sin_[(size_t)i * 256]; }
        const bf16_t* qp = F.Z + (size_t)row0 * ZW + ZQB + hd * 128 + dq * 32;
        const bf16_t* kp = F.Z + (size_t)row0 * ZW + ZKB + hd * 128 + dq * 32;
        const bf16_t* vp = F.Z + (size_t)row0 * ZW + ZVB + hd * 256 + dv * 16 + v;
        const float* dp = F.DEC + (size_t)row0 * 512 + hd * 128 + dq * 32;
        u32x4 qn[4], kn[4]; f32x4 dn[8]; float vn;
#pragma unroll
        for (int c = 0; c < 4; ++c) { qn[c] = *(const u32x4*)(qp + c * 8); kn[c] = *(const u32x4*)(kp + c * 8); }
#pragma unroll
        for (int c = 0; c < 8; ++c) dn[c] = *(const f32x4*)(dp + c * 4);
        vn = bf2f(*vp);
        for (int t = 0; t < T; ++t) {
            u32x4 qc[4], kc[4]; f32x4 dc[8]; const float vv = vn;
#pragma unroll
            for (int c = 0; c < 4; ++c) { qc[c] = qn[c]; kc[c] = kn[c]; }
#pragma unroll
            for (int c = 0; c < 8; ++c) dc[c] = dn[c];
            if (t + 1 < T) { const size_t o = (size_t)(t + 1);
#pragma unroll
                for (int c = 0; c < 4; ++c) { qn[c] = *(const u32x4*)(qp + o * ZW + c * 8); kn[c] = *(const u32x4*)(kp + o * ZW + c * 8); }
#pragma unroll
                for (int c = 0; c < 8; ++c) dn[c] = *(const f32x4*)(dp + o * 512 + c * 4);
                vn = bf2f(vp[o * ZW]); }
            float o_ = 0.f;
#pragma unroll
            for (int c = 0; c < 4; ++c) {
                const unsigned qw[4] = {qc[c].x, qc[c].y, qc[c].z, qc[c].w}, kw[4] = {kc[c].x, kc[c].y, kc[c].z, kc[c].w};
#pragma unroll
                for (int j = 0; j < 4; ++j) { const int i = c * 8 + j * 2;
                    S[i] = dc[i >> 2][i & 3] * S[i] + bflo(kw[j]) * vv; o_ += bflo(qw[j]) * S[i];
                    S[i + 1] = dc[(i + 1) >> 2][(i + 1) & 3] * S[i + 1] + bfhi(kw[j]) * vv; o_ += bfhi(qw[j]) * S[i + 1]; }
            }
            o_ += __shfl_xor(o_, 16); o_ += __shfl_xor(o_, 32);
            if (F.lane < 16) F.GLAO[(size_t)(row0 + t) * 1024 + hd * 256 + dv * 16 + v] = o_;
        }
#pragma unroll
        for (int i = 0; i < 32; ++i) sout[(size_t)i * 256] = S[i];
    }
}
__device__ __forceinline__ void gla_post_phase(const Frame& F, int l) {
    const float* go = F.in[I_GOUT] + l * 256;
    for (int row = F.bid * NWAVE + F.wave; row < MREAL; row += F.G * NWAVE) {
#pragma unroll
        for (int hd = 0; hd < 4; ++hd) {
            const f32x4 o = *(const f32x4*)(F.GLAO + (size_t)row * 1024 + hd * 256 + F.lane * 4);
            float ss = o[0] * o[0] + o[1] * o[1] + o[2] * o[2] + o[3] * o[3];
            ss = wave_sum(ss);
            const float rs = 1.0f / sqrtf(ss * (1.0f / 256.0f) + EPS);
            const f32x4 g = *(const f32x4*)(go + F.lane * 4);
            const u32x2 rr = *(const u32x2*)(F.Z + (size_t)row * ZW + ZRB + hd * 256 + F.lane * 4);
            u32x2 w; w.x = cvt_pk_bf16(o[0] * rs * g[0] * bflo(rr.x), o[1] * rs * g[1] * bfhi(rr.x)); w.y = cvt_pk_bf16(o[2] * rs * g[2] * bflo(rr.y), o[3] * rs * g[3] * bfhi(rr.y));
            *(u32x2*)(F.Y + ((size_t)1 * MP + row) * 1024 + hd * 256 + F.lane * 4) = w;
        }
    }
}

__device__ __forceinline__ float dot64(const u32x4 (&qv)[8], const bf16_t* kp) {
    float s = 0.f;
#pragma unroll
    for (int c = 0; c < 8; ++c) { const u32x4 kv = *(const u32x4*)(kp + c * 8);
        s += bflo(qv[c].x) * bflo(kv.x) + bfhi(qv[c].x) * bfhi(kv.x) + bflo(qv[c].y) * bflo(kv.y) + bfhi(qv[c].y) * bfhi(kv.y)
           + bflo(qv[c].z) * bflo(kv.z) + bfhi(qv[c].z) * bfhi(kv.z) + bflo(qv[c].w) * bflo(kv.w) + bfhi(qv[c].w) * bfhi(kv.w); }
    return s;
}
__device__ __forceinline__ void swa_naive_phase(const Frame& F, int l) {
    const float* sinks = F.in[I_SINK] + l * 16;
    for (int it = F.bid * NWAVE + F.wave; it < NB * TP * 16; it += F.G * NWAVE) {
        const int qh = it & 15, rt = it >> 4, nseq = rt / TP, t = rt - nseq * TP, kvh = qh >> 2;
        const size_t row = (size_t)nseq * TP + t;
        u32x4 qv[8];
#pragma unroll
        for (int c = 0; c < 8; ++c) qv[c] = *(const u32x4*)(F.Z + row * ZW + ZQC + qh * 64 + c * 8);
        float s[2];
#pragma unroll
        for (int hf = 0; hf < 2; ++hf) { const int idx = F.lane + 64 * hf, kt = t - 127 + idx; const bool valid = kt >= 0;
            const size_t krow = (size_t)nseq * TP + (valid ? kt : 0);
            const float dt_ = dot64(qv, F.Z + krow * ZW + ZKC + kvh * 64);
            s[hf] = valid ? dt_ + F.BIAS[qh * 128 + (127 - idx)] : -INFINITY; }
        const float sk = sinks[qh];
        const float m = fmaxf(wave_max(fmaxf(s[0], s[1])), sk);
        const float p0 = __expf(s[0] - m), p1 = __expf(s[1] - m);
        const float den = wave_sum(p0 + p1) + __expf(sk - m);
        float acc = 0.f;
        const bf16_t* vbase = F.Z + ((size_t)nseq * TP + (t - 127)) * ZW + ZVC + kvh * 64 + F.lane;
        const int i0 = (t >= 127) ? 0 : 127 - t;
        for (int idx = i0; idx < 64; ++idx) { const float pj = __uint_as_float(__builtin_amdgcn_readlane(__float_as_uint(p0), idx)); acc += pj * bf2f(vbase[(ptrdiff_t)idx * ZW]); }
        for (int idx = (i0 > 64 ? i0 : 64); idx < 128; ++idx) { const float pj = __uint_as_float(__builtin_amdgcn_readlane(__float_as_uint(p1), idx - 64)); acc += pj * bf2f(vbase[(ptrdiff_t)idx * ZW]); }
        F.Y[((size_t)2 * MP + row) * 1024 + qh * 64 + F.lane] = f2bf(acc / den);
    }
    for (int it = F.bid * NWAVE + F.wave; it < NDEC * 16; it += F.G * NWAVE) {
        const int qh = it & 15, n = it >> 4, kvh = qh >> 2;
        const size_t row = (size_t)ROWS_P + n;
        const float* ck = F.in[I_CK] + (size_t)(l * NDEC + n) * 128 * 256 + kvh * 64;
        const float* cv = F.in[I_CV] + (size_t)(l * NDEC + n) * 128 * 256 + kvh * 64;
        float qf[64];
#pragma unroll
        for (int c = 0; c < 8; ++c) { const u32x4 qq = *(const u32x4*)(F.Z + row * ZW + ZQC + qh * 64 + c * 8);
            qf[c * 8] = bflo(qq.x); qf[c * 8 + 1] = bfhi(qq.x); qf[c * 8 + 2] = bflo(qq.y); qf[c * 8 + 3] = bfhi(qq.y); qf[c * 8 + 4] = bflo(qq.z); qf[c * 8 + 5] = bfhi(qq.z); qf[c * 8 + 6] = bflo(qq.w); qf[c * 8 + 7] = bfhi(qq.w); }
        float s[2];
#pragma unroll
        for (int hf = 0; hf < 2; ++hf) { const int idx = F.lane + 1 + 64 * hf;
            float dt_ = 0.f;
            if (idx < 128) {
#pragma unroll
                for (int c = 0; c < 16; ++c) { const f32x4 kv = *(const f32x4*)(ck + (size_t)idx * 256 + c * 4); dt_ += qf[c * 4] * kv[0] + qf[c * 4 + 1] * kv[1] + qf[c * 4 + 2] * kv[2] + qf[c * 4 + 3] * kv[3]; }
            } else {
#pragma unroll
                for (int c = 0; c < 64; ++c) dt_ += qf[c] * bf2f(F.Z[row * ZW + ZKC + kvh * 64 + c]);
            }
            s[hf] = dt_ + F.BIAS[qh * 128 + (128 - idx)]; }
        const float sk = sinks[qh];
        const float m = fmaxf(wave_max(fmaxf(s[0], s[1])), sk);
        const float p0 = __expf(s[0] - m), p1 = __expf(s[1] - m);
        const float den = wave_sum(p0 + p1) + __expf(sk - m);
        float acc = 0.f;
        for (int j = 0; j < 64; ++j) { const float pj = __uint_as_float(__builtin_amdgcn_readlane(__float_as_uint(p0), j)); acc += pj * cv[(size_t)(j + 1) * 256 + F.lane]; }
        for (int j = 0; j < 63; ++j) { const float pj = __uint_as_float(__builtin_amdgcn_readlane(__float_as_uint(p1), j)); acc += pj * cv[(size_t)(j + 65) * 256 + F.lane]; }
        { const float pj = __uint_as_float(__builtin_amdgcn_readlane(__float_as_uint(p1), 63)); acc += pj * bf2f(F.Z[row * ZW + ZVC + kvh * 64 + F.lane]); }
        F.Y[((size_t)2 * MP + row) * 1024 + qh * 64 + F.lane] = f2bf(acc / den);
    }
    for (int idx = F.bid * NTHR + F.tid; idx < NB * 128 * 256; idx += F.G * NTHR) {
        const int c = idx & 255, j = (idx >> 8) & 127, b = idx >> 15;
        const size_t row = (size_t)b * TP + (TP - 128) + j;
        F.out[O_PSWK + (size_t)l * NB * 128 * 256 + idx] = bf2f(F.Z[row * ZW + ZKC + c]);
        F.out[O_PSWV + (size_t)l * NB * 128 * 256 + idx] = bf2f(F.Z[row * ZW + ZVC + c]);
    }
    for (int idx = F.bid * NTHR + F.tid; idx < NDEC * 128 * 256; idx += F.G * NTHR) {
        const int c = idx & 255, j = (idx >> 8) & 127, n = idx >> 15;
        const size_t row = (size_t)ROWS_P + n;
        float kv, vv;
        if (j < 127) { kv = F.in[I_CK][(size_t)l * NDEC * 128 * 256 + idx + 256]; vv = F.in[I_CV][(size_t)l * NDEC * 128 * 256 + idx + 256]; }
        else { kv = bf2f(F.Z[row * ZW + ZKC + c]); vv = bf2f(F.Z[row * ZW + ZVC + c]); }
        F.out[O_SSWK + (size_t)l * NDEC * 128 * 256 + idx] = kv;
        F.out[O_SSWV + (size_t)l * NDEC * 128 * 256 + idx] = vv;
    }
}

constexpr int NPH = 11, PH_FINAL = 1 + DEPTH * NPH, N_PHASES = PH_FINAL + 1;
#ifndef N_LAUNCH_MODE
#define N_LAUNCH_MODE 1
#endif

__global__ void __launch_bounds__(NTHR, 2) mega(Args a) {
    extern __shared__ __attribute__((aligned(16))) unsigned char lds_raw[];
    Frame F;
    F.in = a.in; F.out = a.out; F.ws = a.ws; F.lds = (LAS unsigned char*)lds_raw;
    F.tid = threadIdx.x; F.lane = F.tid & 63; F.wave = __builtin_amdgcn_readfirstlane(F.tid >> 6); F.G = gridDim.x; F.bid = blockIdx.x;
    unsigned char* ws = a.ws;
    F.Wt_in = (bf16_t*)(ws + WS_WIN); F.Wt_glu = (bf16_t*)(ws + WS_WGLU); F.Wt_up = (bf16_t*)(ws + WS_WUP); F.Wt_out = (bf16_t*)(ws + WS_WOUT); F.Wt_ff1 = (bf16_t*)(ws + WS_WFF1); F.Wt_ff2 = (bf16_t*)(ws + WS_WFF2);
    F.X = (float*)(ws + WS_X); F.H = (bf16_t*)(ws + WS_H); F.AIN = (float*)(ws + WS_AIN); F.Z = (bf16_t*)(ws + WS_Z); F.ZS5 = (bf16_t*)(ws + WS_ZS5); F.Y = (bf16_t*)(ws + WS_Y);
    F.GLAO = (float*)(ws + WS_GLAO); F.DEC = (float*)(ws + WS_DEC); F.MRG = (float*)(ws + WS_MRG); F.MERGED = (bf16_t*)(ws + WS_MERGED); F.MIX = (float*)(ws + WS_MIX); F.FFH = (bf16_t*)(ws + WS_Z);
    F.S5A = (float*)(ws + WS_S5A); F.S5B = (float*)(ws + WS_S5B); F.BIAS = (float*)(ws + WS_BIAS);

    LAS unsigned* misc = (LAS unsigned*)(F.lds + LDS_MISC_OFF);
    if (F.tid < 4) misc[F.tid] = 0u;
    __syncthreads();
    const int lo = a.ph_lo, hi = a.ph_hi;
    XcdBarrier bar; bar.bar = (unsigned*)(ws + WS_CTL); bar.x = 0; bar.st = (volatile LAS unsigned*)misc;
    if (hi - lo > 1) bar = xcd_barrier_post((unsigned*)(ws + WS_CTL), (volatile LAS unsigned*)misc);
#ifndef PHMASK
#define PHMASK 0xFFFF
#endif
#define ON(i) (((PHMASK) >> (i)) & 1)
#define IN(k) (lo <= (k) && (k) < hi)
#define SEAM(k) do { if (IN(k) && IN((k) + 1)) xcd_barrier(bar); } while (0)

    if (ON(12) && IN(0)) { F.fresh(); prologue_phase(F); }
    SEAM(0);
    for (int l = 0; l < DEPTH; ++l) {
        const int pb = 1 + l * NPH;
#define FRESH() F.fresh()
        if (ON(0) && IN(pb + 0)) { FRESH(); if (l == 0) norm_phase<0>(F, 0); else norm_phase<2>(F, l); }
        SEAM(pb + 0);
        if (ON(1) && IN(pb + 1)) { FRESH();
            pg8::Gemm g{F.H, F.Wt_in + (size_t)l * ZW * D, MP, ZW, D}; pg8::StaticOrder S; S.init(MP, ZW, F.G, F.bid);
            pg8::EpiIn E{F.Z, ZW};
            pg8::gemm_phase<pg8::EpiIn, pg8::StaticOrder>(F.lds, g, S, E, nullptr);
        }
        SEAM(pb + 1);
        if (ON(2) && IN(pb + 2)) { FRESH(); gla_pre_phase(F, l); s5_naive_phase(F, l); swa_naive_phase(F, l); }
        SEAM(pb + 2);
        if (ON(3) && IN(pb + 3)) { FRESH(); gla_naive_phase(F, l); }
        SEAM(pb + 3);
        if (ON(4) && IN(pb + 4)) { FRESH(); gla_post_phase(F, l); }
        SEAM(pb + 4);
        if (ON(5) && IN(pb + 5)) { FRESH();
            pg8::Gemm g{F.ZS5, F.Wt_glu + (size_t)l * 1024 * 1024, MP, 1024, 1024}; pg8::StaticOrder S; S.init(MP, 1024, F.G, F.bid);
            pg8::EpiGlu E{F.Y, F.ZS5, F.in[I_BGLU] + l * 1024, 1024};
            pg8::gemm_phase<pg8::EpiGlu, pg8::StaticOrder>(F.lds, g, S, E, nullptr);
        }
        SEAM(pb + 5);
        if (ON(6) && IN(pb + 6)) { FRESH();
            pg8::StaticOrder S; S.init(MP, D, F.G, F.bid);
            { pg8::Gemm g{F.Y, F.Wt_up + ((size_t)l * 3 + 0) * D * 1024, MP, D, 1024}; pg8::EpiMerge<0> E{F.MRG, F.MERGED, F.Z + ZG, ZW}; pg8::gemm_phase<pg8::EpiMerge<0>, pg8::StaticOrder>(F.lds, g, S, E, nullptr); }
            { pg8::Gemm g{F.Y + (size_t)MP * 1024, F.Wt_up + ((size_t)l * 3 + 1) * D * 1024, MP, D, 1024}; pg8::EpiMerge<1> E{F.MRG, F.MERGED, F.Z + ZG + 2048, ZW}; pg8::gemm_phase<pg8::EpiMerge<1>, pg8::StaticOrder>(F.lds, g, S, E, nullptr); }
            { pg8::Gemm g{F.Y + (size_t)2 * MP * 1024, F.Wt_up + ((size_t)l * 3 + 2) * D * 1024, MP, D, 1024}; pg8::EpiMerge<2> E{F.MRG, F.MERGED, F.Z + ZG + 4096, ZW}; pg8::gemm_phase<pg8::EpiMerge<2>, pg8::StaticOrder>(F.lds, g, S, E, nullptr); }
        }
        SEAM(pb + 6);
        if (ON(7) && IN(pb + 7)) { FRESH();
            pg8::Gemm g{F.MERGED, F.Wt_out + (size_t)l * D * D, MP, D, D}; pg8::StaticOrder S; S.init(MP, D, F.G, F.bid);
            pg8::EpiF32 E{F.MIX, D};
            pg8::gemm_phase<pg8::EpiF32, pg8::StaticOrder>(F.lds, g, S, E, nullptr);
        }
        SEAM(pb + 7);
        if (ON(8) && IN(pb + 8)) { FRESH(); norm_phase<1>(F, l); }
        SEAM(pb + 8);
        if (ON(9) && IN(pb + 9)) { FRESH();
            pg8::Gemm g{F.H, F.Wt_ff1 + (size_t)l * DFF * D, MP, DFF, D}; pg8::StaticOrder S; S.init(MP, DFF, F.G, F.bid);
            pg8::EpiFF1 E{F.FFH, DFF};
            pg8::gemm_phase<pg8::EpiFF1, pg8::StaticOrder>(F.lds, g, S, E, nullptr);
        }
        SEAM(pb + 9);
        if (ON(10) && IN(pb + 10)) { FRESH();
            pg8::Gemm g{F.FFH, F.Wt_ff2 + (size_t)l * D * DFF, MP, D, DFF}; pg8::StaticOrder S; S.init(MP, D, F.G, F.bid);
            pg8::EpiF32 E{F.MIX, D};
            pg8::gemm_phase<pg8::EpiF32, pg8::StaticOrder>(F.lds, g, S, E, nullptr);
        }
        SEAM(pb + 10);
    }
    if (ON(11) && IN(PH_FINAL)) { F.fresh(); norm_phase<3>(F, DEPTH); }
#undef IN
#undef SEAM
}

extern "C" void kernel_launch(void* const* d_in, const int* in_sizes, int n_in, void* d_out, int out_size, void* d_ws, size_t ws_size, hipStream_t stream) {
    static int grid = 0;
    if (grid == 0) {
        if (n_in != N_IN || (size_t)out_size != O_END || ws_size < WS_END) {
            fprintf(stderr, "kernel_launch: expected %d inputs, %zu outputs, >= %zu bytes of workspace; got %d, %d, %zu; nothing launched\n", (int)N_IN, (size_t)O_END, (size_t)WS_END, n_in, out_size, ws_size); grid = -1; return; }
        int dev = 0, cus = 0, per_cu = 0;
        if (hipGetDevice(&dev) != hipSuccess || hipDeviceGetAttribute(&cus, hipDeviceAttributeMultiprocessorCount, dev) != hipSuccess) { fprintf(stderr, "kernel_launch: device query failed\n"); grid = -1; return; }
        if (hipFuncSetAttribute((const void*)mega, hipFuncAttributeMaxDynamicSharedMemorySize, LDS_BYTES) != hipSuccess) { fprintf(stderr, "kernel_launch: hipFuncSetAttribute failed\n"); grid = -1; return; }
        if (hipOccupancyMaxActiveBlocksPerMultiprocessor(&per_cu, (const void*)mega, NTHR, LDS_BYTES) != hipSuccess || per_cu < 1) { fprintf(stderr, "kernel_launch: occupancy query says %d blocks per CU\n", per_cu); }
        (void)hipGetLastError();
        grid = cus;
        if (grid > 256) grid = 256;
    }
    if (grid < 0) return;
    if (hipMemsetAsync((char*)d_ws + WS_CTL, 0, WS_CTL_BYTES, stream) != hipSuccess) { fprintf(stderr, "kernel_launch: memset failed\n"); return; }
    Args a{};
    for (int i = 0; i < N_IN; ++i) a.in[i] = (const float*)d_in[i];
    a.out = (float*)d_out; a.ws = (unsigned char*)d_ws;
#if N_LAUNCH_MODE == 1
    a.ph_lo = 0; a.ph_hi = N_PHASES;
    hipLaunchKernelGGL(mega, dim3(grid), dim3(NTHR), LDS_BYTES, stream, a);
#else
    for (int ph = 0; ph < N_PHASES; ++ph) { a.ph_lo = ph; a.ph_hi = ph + 1; hipLaunchKernelGGL(mega, dim3(grid), dim3(NTHR), LDS_BYTES, stream, a); }
#endif
    const hipError_t le = hipPeekAtLastError();
    if (le != hipSuccess) fprintf(stderr, "kernel_launch: launch failed: %s\n", hipGetErrorName(le));
}
```

```cpp
#include <hip/hip_runtime.h>
#include <cstdio>
#include <cstdint>
#include <cstddef>

#define LAS __attribute__((address_space(3)))
typedef unsigned short bf16_t;
typedef short bf16x8 __attribute__((ext_vector_type(8)));
typedef float f32x4 __attribute__((ext_vector_type(4)));
typedef float f32x2 __attribute__((ext_vector_type(2)));
typedef unsigned u32x4 __attribute__((ext_vector_type(4)));
typedef unsigned u32x2 __attribute__((ext_vector_type(2)));

constexpr int D = 2048, NB = 4, SEQ = 2048, NMETA = 16, TP = SEQ + NMETA, NDEC = 32, DEPTH = 4;
constexpr int ROWS_P = NB * TP;
constexpr int MREAL = ROWS_P + NDEC;
constexpr int MP = 8448;
constexpr int INW = 11792, ZW = 11776;
constexpr int ZU = 0, ZQB = 1024, ZKB = 1536, ZVB = 2048, ZRB = 3072, ZQC = 4096, ZKC = 5120, ZVC = 5376, ZG = 5632;
constexpr int DFF = 8192;
constexpr float EPS = 1e-6f;

enum { I_XP = 0, I_XS, I_S5R, I_S5I, I_GLA, I_CK, I_CV, I_META, I_RELB, I_NPM, I_NQM, I_NPF, I_NQF, I_WIN, I_LRE, I_LIM, I_LSTEP, I_BRE, I_BIM, I_CRE, I_CIM, I_SD, I_WGLU, I_BGLU,
       I_WG2, I_BG2, I_GOUT, I_SINK, I_WUS5, I_WUGLA, I_WUSWA, I_WOUT, I_WFF1, I_WFF2, N_IN };

constexpr size_t O_YP = 0, O_YS = O_YP + (size_t)NB * SEQ * D, O_PS5R = O_YS + (size_t)NDEC * D, O_PS5I = O_PS5R + (size_t)DEPTH * NB * 4096,
                 O_PGLA = O_PS5I + (size_t)DEPTH * NB * 4096, O_PSWK = O_PGLA + (size_t)DEPTH * NB * 4 * 128 * 256, O_PSWV = O_PSWK + (size_t)DEPTH * NB * 128 * 256,
                 O_SS5R = O_PSWV + (size_t)DEPTH * NB * 128 * 256, O_SS5I = O_SS5R + (size_t)DEPTH * NDEC * 4096, O_SGLA = O_SS5I + (size_t)DEPTH * NDEC * 4096,
                 O_SSWK = O_SGLA + (size_t)DEPTH * NDEC * 4 * 128 * 256, O_SSWV = O_SSWK + (size_t)DEPTH * NDEC * 128 * 256, O_END = O_SSWV + (size_t)DEPTH * NDEC * 128 * 256;

constexpr size_t al256(size_t x) { return (x + 255) & ~(size_t)255; }
constexpr size_t WS_CTL = 0, WS_CTL_BYTES = 65536;
constexpr size_t WS_WIN = WS_CTL + WS_CTL_BYTES;
constexpr size_t WS_WGLU = WS_WIN + (size_t)DEPTH * ZW * D * 2;
constexpr size_t WS_WUP = WS_WGLU + (size_t)DEPTH * 1024 * 1024 * 2;
constexpr size_t WS_WOUT = WS_WUP + (size_t)DEPTH * 3 * 2048 * 1024 * 2;
constexpr size_t WS_WFF1 = WS_WOUT + (size_t)DEPTH * 2048 * 2048 * 2;
constexpr size_t WS_WFF2 = WS_WFF1 + (size_t)DEPTH * DFF * D * 2;
constexpr size_t WS_X = WS_WFF2 + (size_t)DEPTH * DFF * D * 2;
constexpr size_t WS_H = WS_X + (size_t)MP * D * 4;
constexpr size_t WS_AIN = WS_H + (size_t)MP * D * 2;
constexpr size_t WS_Z = WS_AIN + (size_t)MP * 16 * 4;
constexpr size_t WS_ZS5 = WS_Z + (size_t)MP * ZW * 2;
constexpr size_t WS_Y = WS_ZS5 + (size_t)MP * 1024 * 2;
constexpr size_t WS_GLAO = WS_Y + (size_t)3 * MP * 1024 * 2;
constexpr size_t WS_DEC = WS_GLAO + (size_t)MP * 1024 * 4;
constexpr size_t WS_MRG = WS_DEC + (size_t)MP * 512 * 4;
constexpr size_t WS_MERGED = WS_MRG + (size_t)MP * D * 4;
constexpr size_t WS_MIX = WS_MERGED + (size_t)MP * D * 2;
constexpr size_t WS_S5A = WS_MIX + (size_t)MP * D * 4;
constexpr size_t WS_S5B = WS_S5A + (size_t)DEPTH * 4096 * 2 * 4;
constexpr size_t WS_BIAS = WS_S5B + (size_t)DEPTH * 4096 * 32 * 4;
constexpr size_t WS_VT = WS_BIAS + 16 * 128 * 4;
constexpr size_t WS_END = WS_VT + (size_t)256 * MP * 2;

__device__ __forceinline__ unsigned cvt_pk_bf16(float lo, float hi) { unsigned r; asm volatile("v_cvt_pk_bf16_f32 %0, %1, %2" : "=v"(r) : "v"(lo), "v"(hi)); return r; }
typedef __bf16 bf16x2v __attribute__((ext_vector_type(2)));
typedef float f32x16 __attribute__((ext_vector_type(16)));
__device__ __forceinline__ unsigned pk_bf16(float a, float b) { const f32x2 v = {a, b}; const bf16x2v r = __builtin_convertvector(v, bf16x2v); return __builtin_bit_cast(unsigned, r); }
__device__ __forceinline__ bf16_t f2bf(float f) { return (bf16_t)(cvt_pk_bf16(f, 0.f) & 0xffffu); }
__device__ __forceinline__ float bf2f(bf16_t b) { return __uint_as_float(((unsigned)b) << 16); }
__device__ __forceinline__ float bflo(unsigned u) { return __uint_as_float(u << 16); }
__device__ __forceinline__ float bfhi(unsigned u) { return __uint_as_float(u & 0xffff0000u); }
__device__ __forceinline__ float wave_sum(float v) {
#pragma unroll
    for (int o = 32; o >= 1; o >>= 1) v += __shfl_xor(v, o);
    return v; }
__device__ __forceinline__ float wave_max(float v) {
#pragma unroll
    for (int o = 32; o >= 1; o >>= 1) v = fmaxf(v, __shfl_xor(v, o));
    return v; }
__device__ __forceinline__ float sigmoidf_(float x) { return 1.0f / (1.0f + __expf(-x)); }
__device__ __forceinline__ float gelu_tanh(float y) { const float a = 0.7978845608028654f * (y + 0.044715f * y * y * y); const float e = __expf(2.0f * a); const float th = 1.0f - 2.0f / (e + 1.0f); return 0.5f * y * (1.0f + th); }

#define XB_TMO      128
#define XB_XCNT(j)  (256  + 64 * (j))
#define XB_XSUB(j)  (1280 + 64 * (j))
#define XB_XGEN(j)  (2304 + 64 * (j))
#define XB_TOP      3328
#define XB_TOPGEN   3392
#define XCD_BAR_WORDS 3456
#define XB_SPIN_CAP (1u << 18)

__device__ __forceinline__ unsigned xb_ld(unsigned* p)              { return __hip_atomic_load(p, __ATOMIC_RELAXED, __HIP_MEMORY_SCOPE_AGENT); }
__device__ __forceinline__ unsigned xb_add(unsigned* p, unsigned v) { return __hip_atomic_fetch_add(p, v, __ATOMIC_RELAXED, __HIP_MEMORY_SCOPE_AGENT); }
__device__ __forceinline__ unsigned xb_xcc_id() { return (unsigned)__builtin_amdgcn_s_getreg((3 << 11) | 20) & 0xFu; }
#define XB_SPIN(cond, bar) do { unsigned _sp = 0; while (cond) { __builtin_amdgcn_s_sleep(1); \
    if ((++_sp & 255u) == 0u) { if (xb_ld(&(bar)[XB_TMO])) break; if (_sp > XB_SPIN_CAP) { atomicAdd(&(bar)[XB_TMO], 1u); break; } } } } while (0)

struct XcdBarrier {
    unsigned* bar; unsigned x;
    volatile LAS unsigned* st;
};

__device__ __forceinline__ XcdBarrier xcd_barrier_post(unsigned* bar, volatile LAS unsigned* st) {
    XcdBarrier b; b.bar = bar; b.x = xb_xcc_id(); b.st = st;
    if (threadIdx.x == 0) (void)xb_add(&bar[XB_XCNT(b.x)], 1u);
    return b;
}
__device__ __forceinline__ void xcd_barrier_complete(unsigned* bar, unsigned x, unsigned& nloc, unsigned& nx) {
    const unsigned G = gridDim.x * gridDim.y * gridDim.z;
    unsigned sum, cnt, mine, sp = 0u;
    for (;;) {
        sum = 0u; cnt = 0u; mine = 0u;
#pragma unroll
        for (unsigned j = 0; j < 16; ++j) { const unsigned c = xb_ld(&bar[XB_XCNT(j)]); sum += c; cnt += (c > 0u) ? 1u : 0u; mine = (j == x) ? c : mine; }
        if (sum == G) break;
        __builtin_amdgcn_s_sleep(1);
        if ((++sp & 255u) == 0u) { if (xb_ld(&bar[XB_TMO])) break; if (sp > XB_SPIN_CAP) { atomicAdd(&bar[XB_TMO], 1u); break; } }
    }
    nloc = mine > 0u ? mine : 1u; nx = cnt > 0u ? cnt : 1u;
}

__device__ __forceinline__ void xcd_barrier(const XcdBarrier& b) {
    asm volatile("s_waitcnt vmcnt(0)" ::: "memory");
    __syncthreads();
    if (threadIdx.x == 0) {
        unsigned* bar = b.bar;
        __builtin_amdgcn_s_waitcnt(0);
        unsigned nloc = b.st[0], nx = b.st[1];
        if (nloc == 0u) { xcd_barrier_complete(bar, b.x, nloc, nx); b.st[0] = nloc; b.st[1] = nx; }
        const unsigned old = xb_add(&bar[XB_XSUB(b.x)], 1u);
        const unsigned gen = old / nloc;
        if (old + 1u == (gen + 1u) * nloc) {
            __builtin_amdgcn_fence(__ATOMIC_RELEASE, "agent");
            asm volatile("s_waitcnt vmcnt(0)" ::: "memory");
            const unsigned og = xb_add(&bar[XB_TOP], 1u);
            const unsigned tg = og / nx;
            if (og + 1u == (tg + 1u) * nx) xb_add(&bar[XB_TOPGEN], 1u);
            else XB_SPIN(xb_ld(&bar[XB_TOPGEN]) == tg, bar);
            __builtin_amdgcn_fence(__ATOMIC_ACQUIRE, "agent");
            xb_add(&bar[XB_XGEN(b.x)], 1u);
            asm volatile("s_waitcnt vmcnt(0)" ::: "memory");
        } else {
            XB_SPIN(xb_ld(&bar[XB_XGEN(b.x)]) == gen, bar);
            __builtin_amdgcn_fence(__ATOMIC_ACQUIRE, "agent");
            asm volatile("s_waitcnt vmcnt(0)" ::: "memory");
        }
    }
    __syncthreads();
}

namespace pg8 {
#define PG8_LAS __attribute__((address_space(3)))
typedef unsigned short bf16_t;
typedef short bf16x8 __attribute__((ext_vector_type(8)));
typedef float f32x4 __attribute__((ext_vector_type(4)));
typedef unsigned u32x4 __attribute__((ext_vector_type(4)));
constexpr int BM = 256, BK = 64, HALF = 128, HTB = HALF * BK * 2  , STAGE_BYTES = 8 * HTB, NXCD = 8, WGM = 8;

__host__ __device__ __forceinline__ int lds_byte(int r, int c) { const int st = (r >> 4) * 2 + (c >> 5), rr = r & 15, cc = c & 31, ob = rr * 64 + cc * 2; return st * 1024 + (ob ^ (((ob >> 9) & 1) << 5)); }
__host__ __device__ __forceinline__ void stage_rc(int b, int& R, int& C) { const int st = b / 1024, sb = b % 1024, swz = sb ^ (((sb >> 9) & 1) << 5); R = (st >> 1) * 16 + swz / 64; C = (st & 1) * 32 + (swz % 64) / 2; }
__host__ __device__ __forceinline__ int perm32(int rho) { const int n = rho >> 4, i = rho & 15; return 8 * (i >> 2) + 4 * n + (i & 3); }

struct Unit { int pm, pn; };
struct Gemm { const bf16_t* A; const bf16_t* Bt; int M, N, K; };

struct StaticOrder {
    int nM, nN, nwg, G, c;
    __host__ __device__ void init(int M, int N, int G_, int c_) { nM = M / BM; nN = N / BM; nwg = nM * nN; G = G_; c = c_; }
    __host__ __device__ bool next(int i, Unit& u) const {
        const long L = (long)i * G + c; if (L >= nwg) return false;
        int wgid = (int)L; { const int q = nwg / NXCD, r = nwg % NXCD, xcd = wgid % NXCD, off = wgid / NXCD; wgid = (xcd < r ? xcd * (q + 1) : r * (q + 1) + (xcd - r) * q) + off; }
        const int nig = WGM * nN, gid = wgid / nig, fm = gid * WGM, gsz = (nM - fm) < WGM ? (nM - fm) : WGM;
        u.pm = fm + ((wgid % nig) % gsz); u.pn = (wgid % nig) / gsz; return true;
    }
    __device__ __forceinline__ void a_ready(const Unit&) const {}
    __device__ __forceinline__ void done(const Unit&) const {}
};

__device__ __forceinline__ unsigned cvt_pk_bf16(float lo, float hi) { unsigned r; asm volatile("v_cvt_pk_bf16_f32 %0, %1, %2" : "=v"(r) : "v"(lo), "v"(hi)); return r; }
__device__ __forceinline__ float sigm(float x) { return 1.0f / (1.0f + __expf(-x)); }

struct EpiF32 {
    static constexpr bool PERM = false, AFTER_DRAIN = false;
    float* C; int ldc;
    __device__ __forceinline__ void operator()(const f32x4 (&acc)[2][2][4][2], const Unit& u, int wr, int wc, int fr, int fq) const {
        const int row0 = u.pm * BM + wr * 64 + fr, col0 = u.pn * BM + wc * 32 + 4 * fq;
#pragma unroll
        for (int ai = 0; ai < 2; ++ai)
#pragma unroll
            for (int m = 0; m < 4; ++m) { float* rowp = C + (size_t)(row0 + ai * HALF + m * 16) * ldc + col0;
#pragma unroll
                for (int bj = 0; bj < 2; ++bj)
#pragma unroll
                    for (int n = 0; n < 2; ++n) *(f32x4*)(rowp + bj * HALF + n * 16) = acc[ai][bj][m][n]; }
    }
};
struct EpiIn {
    static constexpr bool PERM = true, AFTER_DRAIN = false;
    bf16_t* O; int ldc; bf16_t* VT; int ldvt;
    __device__ __forceinline__ void operator()(const f32x4 (&acc)[2][2][4][2], const Unit& u, int wr, int wc, int fr, int fq) const {
        const int row0 = u.pm * BM + wr * 64 + fr, col0 = u.pn * BM + wc * 32 + 8 * fq;
        const int pn = u.pn;
        const int act = (pn >= 22) ? 1 : ((pn >= 12 && pn < 16) ? 2 : ((pn == 4 || pn == 5 || (pn >= 16 && pn < 20)) ? 3 : 0));
        const float sc = (pn == 4 || pn == 5) ? 0.08838834764831845f : 0.125f;
#pragma unroll
        for (int ai = 0; ai < 2; ++ai)
#pragma unroll
            for (int m = 0; m < 4; ++m) { bf16_t* rowp = O + (size_t)(row0 + ai * HALF + m * 16) * ldc + col0;
#pragma unroll
                for (int bj = 0; bj < 2; ++bj) { f32x4 v0 = acc[ai][bj][m][0], v1 = acc[ai][bj][m][1];
                    if (act == 1) {
#pragma unroll
                        for (int j = 0; j < 4; ++j) { v0[j] = sigm(v0[j]); v1[j] = sigm(v1[j]); } }
                    else if (act == 2) {
#pragma unroll
                        for (int j = 0; j < 4; ++j) { v0[j] = v0[j] * sigm(v0[j]); v1[j] = v1[j] * sigm(v1[j]); } }
                    else if (act == 3) { v0 = v0 * sc; v1 = v1 * sc; }
                    u32x4 w; w.x = cvt_pk_bf16(v0[0], v0[1]); w.y = cvt_pk_bf16(v0[2], v0[3]); w.z = cvt_pk_bf16(v1[0], v1[1]); w.w = cvt_pk_bf16(v1[2], v1[3]);
                    *(u32x4*)(rowp + bj * HALF) = w;
                    if (pn == 21) { bf16_t* vt = VT + (size_t)(wc * 32 + 8 * fq + bj * HALF) * ldvt + (row0 + ai * HALF + m * 16);
                        vt[0] = (bf16_t)(w.x & 0xffffu); vt[(size_t)ldvt] = (bf16_t)(w.x >> 16); vt[(size_t)2 * ldvt] = (bf16_t)(w.y & 0xffffu); vt[(size_t)3 * ldvt] = (bf16_t)(w.y >> 16);
                        vt[(size_t)4 * ldvt] = (bf16_t)(w.z & 0xffffu); vt[(size_t)5 * ldvt] = (bf16_t)(w.z >> 16); vt[(size_t)6 * ldvt] = (bf16_t)(w.w & 0xffffu); vt[(size_t)7 * ldvt] = (bf16_t)(w.w >> 16); } } }
    }
};
struct EpiFF1 {
    static constexpr bool PERM = true, AFTER_DRAIN = false;
    bf16_t* O; int ldc;
    __device__ __forceinline__ void operator()(const f32x4 (&acc)[2][2][4][2], const Unit& u, int wr, int wc, int fr, int fq) const {
        const int row0 = u.pm * BM + wr * 64 + fr, col0 = u.pn * BM + wc * 32 + 8 * fq;
#pragma unroll
        for (int ai = 0; ai < 2; ++ai)
#pragma unroll
            for (int m = 0; m < 4; ++m) { bf16_t* rowp = O + (size_t)(row0 + ai * HALF + m * 16) * ldc + col0;
#pragma unroll
                for (int bj = 0; bj < 2; ++bj) { f32x4 v0 = acc[ai][bj][m][0], v1 = acc[ai][bj][m][1];
#pragma unroll
                    for (int j = 0; j < 4; ++j) { const float a = fmaxf(v0[j], 0.f), b = fmaxf(v1[j], 0.f); v0[j] = a * a; v1[j] = b * b; }
                    u32x4 w; w.x = cvt_pk_bf16(v0[0], v0[1]); w.y = cvt_pk_bf16(v0[2], v0[3]); w.z = cvt_pk_bf16(v1[0], v1[1]); w.w = cvt_pk_bf16(v1[2], v1[3]);
                    *(u32x4*)(rowp + bj * HALF) = w; } }
    }
};
struct EpiGlu {
    static constexpr bool PERM = true, AFTER_DRAIN = false;
    bf16_t* O; const bf16_t* Zs; const float* bias; int ldc;
    __device__ __forceinline__ void operator()(const f32x4 (&acc)[2][2][4][2], const Unit& u, int wr, int wc, int fr, int fq) const {
        const int row0 = u.pm * BM + wr * 64 + fr, col0 = u.pn * BM + wc * 32 + 8 * fq;
        f32x4 bv[2][2];
#pragma unroll
        for (int bj = 0; bj < 2; ++bj)
#pragma unroll
            for (int n = 0; n < 2; ++n) bv[bj][n] = *(const f32x4*)(bias + col0 + bj * HALF + 4 * n);
#pragma unroll
        for (int ai = 0; ai < 2; ++ai)
#pragma unroll
            for (int m = 0; m < 4; ++m) { const size_t ro = (size_t)(row0 + ai * HALF + m * 16) * ldc + col0;
#pragma unroll
                for (int bj = 0; bj < 2; ++bj) { f32x4 v0 = acc[ai][bj][m][0] + bv[bj][0], v1 = acc[ai][bj][m][1] + bv[bj][1];
                    const u32x4 zz = *(const u32x4*)(Zs + ro + bj * HALF);
                    const float z0 = __uint_as_float(zz.x << 16), z1 = __uint_as_float(zz.x & 0xffff0000u), z2 = __uint_as_float(zz.y << 16), z3 = __uint_as_float(zz.y & 0xffff0000u);
                    const float z4 = __uint_as_float(zz.z << 16), z5 = __uint_as_float(zz.z & 0xffff0000u), z6 = __uint_as_float(zz.w << 16), z7 = __uint_as_float(zz.w & 0xffff0000u);
                    u32x4 w; w.x = cvt_pk_bf16(z0 * sigm(v0[0]), z1 * sigm(v0[1])); w.y = cvt_pk_bf16(z2 * sigm(v0[2]), z3 * sigm(v0[3]));
                    w.z = cvt_pk_bf16(z4 * sigm(v1[0]), z5 * sigm(v1[1])); w.w = cvt_pk_bf16(z6 * sigm(v1[2]), z7 * sigm(v1[3]));
                    *(u32x4*)(O + ro + bj * HALF) = w; } }
    }
};
template <int KB> struct EpiMerge {
    static constexpr bool PERM = false, AFTER_DRAIN = false;
    float* mrg; bf16_t* out; const bf16_t* gate; int ldg;
    __device__ __forceinline__ void operator()(const f32x4 (&acc)[2][2][4][2], const Unit& u, int wr, int wc, int fr, int fq) const {
        const int row0 = u.pm * BM + wr * 64 + fr, col0 = u.pn * BM + wc * 32 + 4 * fq;
#pragma unroll
        for (int ai = 0; ai < 2; ++ai)
#pragma unroll
            for (int m = 0; m < 4; ++m) { const size_t r = (size_t)(row0 + ai * HALF + m * 16);
#pragma unroll
                for (int bj = 0; bj < 2; ++bj)
#pragma unroll
                    for (int n = 0; n < 2; ++n) { const int c = col0 + bj * HALF + n * 16;
                        const u32x2 gg = *(const u32x2*)(gate + r * ldg + c);
                        f32x4 gv; gv[0] = __uint_as_float(gg.x << 16); gv[1] = __uint_as_float(gg.x & 0xffff0000u); gv[2] = __uint_as_float(gg.y << 16); gv[3] = __uint_as_float(gg.y & 0xffff0000u);
                        f32x4 v = gv * acc[ai][bj][m][n];
                        if (KB >= 1) v = v + *(const f32x4*)(mrg + r * 2048 + c);
                        if (KB <= 1) *(f32x4*)(mrg + r * 2048 + c) = v;
                        else { u32x2 w; w.x = cvt_pk_bf16(v[0], v[1]); w.y = cvt_pk_bf16(v[2], v[3]); *(u32x2*)(out + r * 2048 + c) = w; } }
                asm volatile("" ::: "memory"); }
    }
};

template <class Epi, class Sched, bool STAMP = false>
__device__ __forceinline__ void gemm_phase(PG8_LAS unsigned char* lds, const Gemm g, const Sched& S, const Epi& E, unsigned long long* stamps) {
    int tid_ = threadIdx.x; asm volatile("" : "+v"(tid_)); const int tid = tid_, wid = __builtin_amdgcn_readfirstlane(tid >> 6), lane = tid & 63, wr = wid >> 2, wc = wid & 3, fr = lane & 15, fq = lane >> 4;
    const int K = g.K, nt = K / BK;
    int ts_lo = 0, ts_hi = 0, nts = 0; const unsigned long long rt_entry = STAMP ? (unsigned long long)wall_clock64() : 0ull;
#define PG8_STAMP() do { if (STAMP && wid == 0 && nts < 64) { const unsigned long long _c = (unsigned long long)clock64(); \
        ts_lo = (lane == nts) ? (int)(unsigned)_c : ts_lo; ts_hi = (lane == nts) ? (int)(unsigned)(_c >> 32) : ts_hi; ++nts; } } while (0)
    PG8_STAMP();
    unsigned voffA[2], voffB[2];
#pragma unroll
    for (int i = 0; i < 2; ++i) { int R, C; stage_rc(tid * 16 + i * 8192, R, C); const int Rb = Epi::PERM ? ((R & ~31) + perm32(R & 31)) : R;
        voffA[i] = (unsigned)(R * K + C) * 2u; voffB[i] = (unsigned)(Rb * K + C) * 2u; }
    const size_t kstep = (size_t)(BK * 2);
    const size_t hstep = (size_t)HALF * K * 2;
    const size_t tstep = 2 * hstep;
    const unsigned ldsw = (unsigned)wid * 1024u;
    const int aoff = lds_byte(wr * 64 + fr, fq * 8), boff = lds_byte(wc * 32 + fr, fq * 8);
#define PG8_SA(b, h) (((b) * 2 + (h)) * HTB)
#define PG8_SB(b, h) ((4 + (b) * 2 + (h)) * HTB)
#define PG8_STAGE(bufoff, gbase, voff) do { _Pragma("unroll") for (int _i = 0; _i < 2; ++_i) \
        __builtin_amdgcn_global_load_lds((const unsigned*)((const char*)(gbase) + (voff)[_i]), (PG8_LAS unsigned*)(lds + (bufoff) + ldsw + _i * 8192), 16, 0, 0); } while (0)
#define PG8_LDA(dst, b, h) do { _Pragma("unroll") for (int m = 0; m < 4; ++m) _Pragma("unroll") for (int k = 0; k < 2; ++k) dst[m][k] = *(const PG8_LAS bf16x8*)(lds + PG8_SA(b, h) + aoff + m * 2048 + k * 1024); } while (0)
#define PG8_LDB(dst, b, h) do { _Pragma("unroll") for (int n = 0; n < 2; ++n) _Pragma("unroll") for (int k = 0; k < 2; ++k) dst[n][k] = *(const PG8_LAS bf16x8*)(lds + PG8_SB(b, h) + boff + n * 2048 + k * 1024); } while (0)
#define PG8_MMA(ai, bj, At, Bt) do { __builtin_amdgcn_s_setprio(1); _Pragma("unroll") for (int m = 0; m < 4; ++m) _Pragma("unroll") for (int n = 0; n < 2; ++n) _Pragma("unroll") for (int k = 0; k < 2; ++k) \
        acc[ai][bj][m][n] = __builtin_amdgcn_mfma_f32_16x16x32_bf16(Bt[n][k], At[m][k], acc[ai][bj][m][n], 0, 0, 0); __builtin_amdgcn_s_setprio(0); } while (0)
#define PG8_WAIT_V(n) asm volatile("s_waitcnt vmcnt(" #n ")" ::: "memory")
#define PG8_WAIT_L(n) asm volatile("s_waitcnt lgkmcnt(" #n ")" ::: "memory")
#define PG8_BAR __builtin_amdgcn_s_barrier()
#define PG8_SCHED __builtin_amdgcn_sched_barrier(0)
    Unit cur, nxt; int ui = 0;
    if (!S.next(0, cur)) return;
    f32x4 acc[2][2][4][2];
#pragma unroll
    for (int a = 0; a < 2; ++a)
#pragma unroll
        for (int b = 0; b < 2; ++b)
#pragma unroll
            for (int m = 0; m < 4; ++m)
#pragma unroll
                for (int n = 0; n < 2; ++n) acc[a][b][m][n] = (f32x4){0.f, 0.f, 0.f, 0.f};
    bf16x8 At[4][2], B0[2][2], B1[2][2];
    const char* cA = (const char*)g.A + (size_t)cur.pm * tstep; const char* cB = (const char*)g.Bt + (size_t)cur.pn * tstep;
    S.a_ready(cur);
    PG8_STAGE(PG8_SB(0, 0), cB, voffB); PG8_STAGE(PG8_SA(0, 0), cA, voffA); PG8_STAGE(PG8_SB(0, 1), cB + hstep, voffB); PG8_STAGE(PG8_SA(0, 1), cA + hstep, voffA);
    if (wr == 1) PG8_BAR;
    PG8_WAIT_V(4); PG8_BAR;
    PG8_STAGE(PG8_SB(1, 0), cB + kstep, voffB); PG8_STAGE(PG8_SA(1, 0), cA + kstep, voffA); PG8_STAGE(PG8_SB(1, 1), cB + hstep + kstep, voffB);
    PG8_WAIT_V(6); PG8_BAR;
    PG8_STAMP();
    for (;;) {
        const bool has_next = S.next(ui + 1, nxt);
        const char* nA = has_next ? (const char*)g.A + (size_t)nxt.pm * tstep : cA; const char* nB = has_next ? (const char*)g.Bt + (size_t)nxt.pn * tstep : cB;
        for (int t = 0; t < nt; t += 2) {
            const bool last = (t == nt - 2);
            const char* a1 = cA + (size_t)(t + 1) * kstep;
            const char* a2 = last ? nA : cA + (size_t)(t + 2) * kstep; const char* b2 = last ? nB : cB + (size_t)(t + 2) * kstep;
            const char* a3 = a2 + kstep; const char* b3 = b2 + kstep;
            if (last && has_next) S.a_ready(nxt);
            PG8_LDB(B0, 0, 0); PG8_SCHED; PG8_LDA(At, 0, 0); PG8_STAGE(PG8_SA(1, 1), a1 + hstep, voffA);
            PG8_WAIT_L(8); PG8_BAR; PG8_WAIT_L(0); PG8_MMA(0, 0, At, B0); PG8_BAR; PG8_SCHED;
            PG8_LDB(B1, 0, 1); PG8_STAGE(PG8_SB(0, 0), b2, voffB);
            PG8_BAR; PG8_WAIT_L(0); PG8_MMA(0, 1, At, B1); PG8_BAR;
            PG8_LDA(At, 0, 1); PG8_STAGE(PG8_SA(0, 0), a2, voffA);
            PG8_BAR; PG8_WAIT_L(0); PG8_MMA(1, 0, At, B0); PG8_BAR; PG8_SCHED;
            PG8_STAGE(PG8_SB(0, 1), b2 + hstep, voffB);
            PG8_WAIT_V(6); PG8_BAR; PG8_MMA(1, 1, At, B1); PG8_BAR;
            PG8_LDB(B0, 1, 0); PG8_SCHED; PG8_LDA(At, 1, 0); PG8_STAGE(PG8_SA(0, 1), a2 + hstep, voffA);
            PG8_WAIT_L(8); PG8_BAR; PG8_WAIT_L(0); PG8_MMA(0, 0, At, B0); PG8_BAR; PG8_SCHED;
            PG8_LDB(B1, 1, 1); PG8_STAGE(PG8_SB(1, 0), b3, voffB);
            PG8_BAR; PG8_WAIT_L(0); PG8_MMA(0, 1, At, B1); PG8_BAR;
            PG8_LDA(At, 1, 1); PG8_STAGE(PG8_SA(1, 0), a3, voffA);
            PG8_BAR; PG8_WAIT_L(0); PG8_MMA(1, 0, At, B0); PG8_BAR; PG8_SCHED;
            PG8_STAGE(PG8_SB(1, 1), b3 + hstep, voffB);
            PG8_WAIT_V(6); PG8_BAR; PG8_MMA(1, 1, At, B1); PG8_BAR;
        }
        PG8_STAMP();
        if constexpr (!Epi::AFTER_DRAIN) { E(acc, cur, wr, wc, fr, fq); S.done(cur); }
        PG8_STAMP();
        if (!has_next) break;
#pragma unroll
        for (int a = 0; a < 2; ++a)
#pragma unroll
            for (int b = 0; b < 2; ++b)
#pragma unroll
                for (int m = 0; m < 4; ++m)
#pragma unroll
                    for (int n = 0; n < 2; ++n) acc[a][b][m][n] = (f32x4){0.f, 0.f, 0.f, 0.f};
        cur = nxt; cA = nA; cB = nB; ++ui;
    }
    PG8_WAIT_V(0);
    if (wr == 0) PG8_BAR;
    PG8_BAR;
    if constexpr (Epi::AFTER_DRAIN) { E.fused(acc, cur, wr, wc, fr, fq, lds, wid, lane); S.done(cur); }
    PG8_STAMP();
    if (STAMP && wid == 0) { stamps[lane] = lane < nts ? (((unsigned long long)(unsigned)ts_hi << 32) | (unsigned)ts_lo) : 0ull;
        if (lane == 62) stamps[62] = rt_entry; if (lane == 63) stamps[63] = (unsigned long long)wall_clock64(); }
#undef PG8_STAMP
#undef PG8_SA
#undef PG8_SB
#undef PG8_STAGE
#undef PG8_LDA
#undef PG8_LDB
#undef PG8_MMA
#undef PG8_WAIT_V
#undef PG8_WAIT_L
#undef PG8_BAR
#undef PG8_SCHED
}
}

constexpr int NTHR = 512, NWAVE = 8;
constexpr int LDS_STAGE = 131072, LDS_MISC_OFF = LDS_STAGE, LDS_BYTES = LDS_STAGE + 4096;

struct Args { const float* in[N_IN]; float* out; unsigned char* ws; int ph_lo, ph_hi; };

struct Frame {
    const float* const* in; float* out; unsigned char* ws; LAS unsigned char* lds;
    int tid, lane, wave, G, bid;
    __device__ __forceinline__ void fresh() { int t = threadIdx.x; asm volatile("" : "+v"(t)); tid = t; lane = t & 63; wave = __builtin_amdgcn_readfirstlane(t >> 6); int b = blockIdx.x; asm volatile("" : "+s"(b)); bid = b; }
    bf16_t *Wt_in, *Wt_glu, *Wt_up, *Wt_out, *Wt_ff1, *Wt_ff2;
    float* X; bf16_t* H; float* AIN; bf16_t* Z; bf16_t* ZS5; bf16_t* Y; float* GLAO; float* DEC; float* MRG; bf16_t* MERGED; float* MIX; bf16_t* FFH;
    float* S5A; float* S5B; float* BIAS; bf16_t* VT;
};

__device__ __forceinline__ void transpose_convert(const Frame& F, const float* __restrict__ src, bf16_t* __restrict__ dst, int K, int ld, int N, bool is_in) {
    const int ntn = N / 64, ntiles = ntn * (K / 64);
    for (int tile = F.bid * NWAVE + F.wave; tile < ntiles; tile += F.G * NWAVE) {
        const int kt = tile / ntn, nt = tile - kt * ntn, n0 = nt * 64, k0 = kt * 64;
        int sc = n0 + F.lane; if (is_in && sc >= 3072) sc += 16;
        const float* sp = src + (size_t)k0 * ld + sc;
        float v[64];
#pragma unroll
        for (int i = 0; i < 64; ++i) v[i] = sp[(size_t)i * ld];
        u32x4* dp = (u32x4*)(dst + (size_t)(n0 + F.lane) * K + k0);
#pragma unroll
        for (int j = 0; j < 8; ++j) { u32x4 w; w.x = cvt_pk_bf16(v[8 * j], v[8 * j + 1]); w.y = cvt_pk_bf16(v[8 * j + 2], v[8 * j + 3]); w.z = cvt_pk_bf16(v[8 * j + 4], v[8 * j + 5]); w.w = cvt_pk_bf16(v[8 * j + 6], v[8 * j + 7]); dp[j] = w; }
    }
}
__device__ __forceinline__ void prologue_phase(const Frame& F) {
    for (int l = 0; l < DEPTH; ++l) {
        transpose_convert(F, F.in[I_WIN] + (size_t)l * D * INW, F.Wt_in + (size_t)l * ZW * D, D, INW, ZW, true);
        transpose_convert(F, F.in[I_WGLU] + (size_t)l * 1024 * 1024, F.Wt_glu + (size_t)l * 1024 * 1024, 1024, 1024, 1024, false);
        transpose_convert(F, F.in[I_WUS5] + (size_t)l * 1024 * D, F.Wt_up + ((size_t)l * 3 + 0) * D * 1024, 1024, D, D, false);
        transpose_convert(F, F.in[I_WUGLA] + (size_t)l * 1024 * D, F.Wt_up + ((size_t)l * 3 + 1) * D * 1024, 1024, D, D, false);
        transpose_convert(F, F.in[I_WUSWA] + (size_t)l * 1024 * D, F.Wt_up + ((size_t)l * 3 + 2) * D * 1024, 1024, D, D, false);
        transpose_convert(F, F.in[I_WOUT] + (size_t)l * D * D, F.Wt_out + (size_t)l * D * D, D, D, D, false);
        transpose_convert(F, F.in[I_WFF1] + (size_t)l * D * DFF, F.Wt_ff1 + (size_t)l * DFF * D, D, DFF, DFF, false);
        transpose_convert(F, F.in[I_WFF2] + (size_t)l * DFF * D, F.Wt_ff2 + (size_t)l * D * DFF, DFF, D, D, false);
    }
    for (int idx = F.bid * NTHR + F.tid; idx < DEPTH * 4096; idx += F.G * NTHR) {
        const int l = idx >> 12, g = (idx >> 6) & 63;
        const double dt = exp((double)F.in[I_LSTEP][l * 64 + g]);
        const double lr = (double)F.in[I_LRE][idx], li = (double)F.in[I_LIM][idx];
        const double mag = exp(lr * dt), ar = mag * cos(li * dt), ai = mag * sin(li * dt);
        const double den = lr * lr + li * li;
        const double fr = ((ar - 1.0) * lr + ai * li) / den, fi = (ai * lr - (ar - 1.0) * li) / den;
        F.S5A[idx * 2 + 0] = (float)ar; F.S5A[idx * 2 + 1] = (float)ai;
        const float* br = F.in[I_BRE] + (size_t)idx * 16; const float* bi = F.in[I_BIM] + (size_t)idx * 16;
        float* o = F.S5B + (size_t)idx * 32;
#pragma unroll
        for (int h = 0; h < 16; ++h) { const double b_r = br[h], b_i = bi[h]; o[h] = (float)(fr * b_r - fi * b_i); o[16 + h] = (float)(fr * b_i + fi * b_r); }
    }
    for (int idx = F.bid * NTHR + F.tid; idx < 16 * 128; idx += F.G * NTHR) {
        const int hq = idx >> 7, d = idx & 127;
        int bucket = d;
        if (d >= 16) { bucket = 16 + (int)(log((double)d / 16.0) / log(8.0) * 16.0); if (bucket > 31) bucket = 31; }
        F.BIAS[idx] = F.in[I_RELB][bucket * 16 + hq];
    }
}

template <int MODE>
__device__ __forceinline__ void norm_phase(const Frame& F, int l) {
    constexpr bool AIN = (MODE == 0 || MODE == 2);
    const float* gA = (MODE == 1) ? F.in[I_NQM] + l * D : (MODE == 2) ? F.in[I_NQF] + (l - 1) * D : F.in[I_NQF] + 3 * D;
    const float* gB = (MODE == 0) ? F.in[I_NPM] : (MODE == 1) ? F.in[I_NPF] + l * D : F.in[I_NPM] + l * D;
    LAS f32x4* WaL = (LAS f32x4*)F.lds;
    if (AIN) {
        const float* wl = F.in[I_WIN] + (size_t)l * D * INW + 3072;
        for (int idx = F.tid; idx < 2048 * 4; idx += NTHR) { const int k = idx >> 2, nq = idx & 3;
            const f32x4 w = *(const f32x4*)(wl + (size_t)k * INW + nq * 4);
            const int kk = k >> 8, ln = (k & 255) >> 2, j = k & 3;
            WaL[((kk * 4 + j) * 4 + nq) * 64 + ln] = w; }
        __syncthreads();
    }
    for (int row = F.bid * NWAVE + F.wave; row < MP; row += F.G * NWAVE) {
        if (row >= MREAL) {
            if (MODE == 0) { const f32x4 z4 = {0.f, 0.f, 0.f, 0.f}; const u32x2 z2 = {0u, 0u};
#pragma unroll
                for (int kk = 0; kk < 8; ++kk) { ((f32x4*)(F.X + (size_t)row * D))[kk * 64 + F.lane] = z4; ((u32x2*)(F.H + (size_t)row * D))[kk * 64 + F.lane] = z2; }
                if (F.lane < 16) F.AIN[row * 16 + F.lane] = 0.f; }
            continue;
        }
        f32x4 xv[8];
        const f32x4* xs;
        if (MODE == 0) {
            if (row < ROWS_P) { const int b = row / TP, t = row - b * TP; xs = (t < NMETA) ? (const f32x4*)(F.in[I_META] + (size_t)t * D) : (const f32x4*)(F.in[I_XP] + ((size_t)b * SEQ + (t - NMETA)) * D); }
            else xs = (const f32x4*)(F.in[I_XS] + (size_t)(row - ROWS_P) * D);
        } else xs = (const f32x4*)(F.X + (size_t)row * D);
#pragma unroll
        for (int kk = 0; kk < 8; ++kk) xv[kk] = xs[kk * 64 + F.lane];
        if (MODE != 0) {
            const f32x4* rs_ = (const f32x4*)(F.MIX + (size_t)row * D);
            f32x4 rv[8]; float ss = 0.f;
#pragma unroll
            for (int kk = 0; kk < 8; ++kk) { rv[kk] = rs_[kk * 64 + F.lane]; ss += rv[kk][0] * rv[kk][0] + rv[kk][1] * rv[kk][1] + rv[kk][2] * rv[kk][2] + rv[kk][3] * rv[kk][3]; }
            ss = wave_sum(ss);
            const float rs = 1.0f / sqrtf(ss * (1.0f / D) + EPS);
#pragma unroll
            for (int kk = 0; kk < 8; ++kk) { const f32x4 ga = ((const f32x4*)gA)[kk * 64 + F.lane]; xv[kk] = xv[kk] + rv[kk] * rs * ga; }
        }
        if (MODE == 3) {
            f32x4* od = nullptr;
            if (row < ROWS_P) { const int b = row / TP, t = row - b * TP; if (t >= NMETA) od = (f32x4*)(F.out + O_YP + ((size_t)b * SEQ + (t - NMETA)) * D); }
            else od = (f32x4*)(F.out + O_YS + (size_t)(row - ROWS_P) * D);
            if (od) {
#pragma unroll
                for (int kk = 0; kk < 8; ++kk) od[kk * 64 + F.lane] = xv[kk]; }
            continue;
        }
#pragma unroll
        for (int kk = 0; kk < 8; ++kk) ((f32x4*)(F.X + (size_t)row * D))[kk * 64 + F.lane] = xv[kk];
        float ss2 = 0.f;
#pragma unroll
        for (int kk = 0; kk < 8; ++kk) ss2 += xv[kk][0] * xv[kk][0] + xv[kk][1] * xv[kk][1] + xv[kk][2] * xv[kk][2] + xv[kk][3] * xv[kk][3];
        ss2 = wave_sum(ss2);
        const float rs2 = 1.0f / sqrtf(ss2 * (1.0f / D) + EPS);
#pragma unroll
        for (int kk = 0; kk < 8; ++kk) { const f32x4 gb = ((const f32x4*)gB)[kk * 64 + F.lane]; xv[kk] = xv[kk] * rs2 * gb;
            u32x2 w; w.x = cvt_pk_bf16(xv[kk][0], xv[kk][1]); w.y = cvt_pk_bf16(xv[kk][2], xv[kk][3]); ((u32x2*)(F.H + (size_t)row * D))[kk * 64 + F.lane] = w; }
        if (AIN) {
            float acc[16];
#pragma unroll
            for (int n = 0; n < 16; ++n) acc[n] = 0.f;
#pragma unroll
            for (int kk = 0; kk < 8; ++kk)
#pragma unroll
                for (int j = 0; j < 4; ++j) { const float hv = xv[kk][j];
#pragma unroll
                    for (int nq = 0; nq < 4; ++nq) { const f32x4 w = WaL[((kk * 4 + j) * 4 + nq) * 64 + F.lane];
                        acc[nq * 4 + 0] += hv * w[0]; acc[nq * 4 + 1] += hv * w[1]; acc[nq * 4 + 2] += hv * w[2]; acc[nq * 4 + 3] += hv * w[3]; } }
#pragma unroll
            for (int n = 0; n < 16; ++n) acc[n] = wave_sum(acc[n]);
            float mine = 0.f;
#pragma unroll
            for (int n = 0; n < 16; ++n) mine = (F.lane == n) ? acc[n] : mine;
            if (F.lane < 16) F.AIN[row * 16 + F.lane] = mine;
        }
    }
    if (AIN) __syncthreads();
}

__device__ __forceinline__ void gla_pre_phase(const Frame& F, int l) {
    const int t = F.tid & 127, sub = F.tid >> 7;
    const float* wg = F.in[I_WG2] + (size_t)l * 16 * 512 + 4 * t;
    f32x4 w[16];
#pragma unroll
    for (int r = 0; r < 16; ++r) w[r] = *(const f32x4*)(wg + r * 512);
    const f32x4 bg = *(const f32x4*)(F.in[I_BG2] + l * 512 + 4 * t);
    for (int row = F.bid * 4 + sub; row < MREAL; row += F.G * 4) {
        f32x4 a[4];
#pragma unroll
        for (int q = 0; q < 4; ++q) a[q] = *(const f32x4*)(F.AIN + row * 16 + q * 4);
        f32x4 pre = bg;
#pragma unroll
        for (int r = 0; r < 16; ++r) pre = pre + w[r] * a[r >> 2][r & 3];
        f32x4 o;
#pragma unroll
        for (int c = 0; c < 4; ++c) { const float x = pre[c]; const float ls = fminf(x, 0.f) - log1pf(expf(-fabsf(x))); o[c] = expf(ls * 0.0625f); }
        *(f32x4*)(F.DEC + (size_t)row * 512 + 4 * t) = o;
    }
}

__device__ __forceinline__ void s5_naive_phase(const Frame& F, int l) {
    LAS f32x2* sx = (LAS f32x2*)F.lds + F.wave * 64;
    const int p = F.lane, h = F.lane & 15, q = F.lane >> 4;
    for (int it = F.wave * F.G + F.bid; it < 36 * 64; it += F.G * NWAVE) {
        int g, T, row0, nseq; bool prompt;
        if (it < 256) { nseq = it >> 6; g = it & 63; T = TP; row0 = nseq * TP; prompt = true; }
        else { const int j = it - 256; nseq = j >> 6; g = j & 63; T = 1; row0 = ROWS_P + nseq; prompt = false; }
        const int gi = (l * 64 + g) * 64 + p;
        const float ar = F.S5A[gi * 2], ai = F.S5A[gi * 2 + 1];
        float bbr[16], bbi[16];
#pragma unroll
        for (int c = 0; c < 4; ++c) { const f32x4 a = *(const f32x4*)(F.S5B + (size_t)gi * 32 + c * 4), b = *(const f32x4*)(F.S5B + (size_t)gi * 32 + 16 + c * 4);
            bbr[c * 4] = a[0]; bbr[c * 4 + 1] = a[1]; bbr[c * 4 + 2] = a[2]; bbr[c * 4 + 3] = a[3]; bbi[c * 4] = b[0]; bbi[c * 4 + 1] = b[1]; bbi[c * 4 + 2] = b[2]; bbi[c * 4 + 3] = b[3]; }
        float cr[16], ci[16];
        { const float* crp = F.in[I_CRE] + ((size_t)(l * 64 + g) * 16 + h) * 64 + q * 16; const float* cip = F.in[I_CIM] + ((size_t)(l * 64 + g) * 16 + h) * 64 + q * 16;
#pragma unroll
            for (int c = 0; c < 4; ++c) { const f32x4 a = *(const f32x4*)(crp + c * 4), b = *(const f32x4*)(cip + c * 4);
                cr[c * 4] = a[0]; cr[c * 4 + 1] = a[1]; cr[c * 4 + 2] = a[2]; cr[c * 4 + 3] = a[3]; ci[c * 4] = b[0]; ci[c * 4 + 1] = b[1]; ci[c * 4 + 2] = b[2]; ci[c * 4 + 3] = b[3]; } }
        const float dsk = F.in[I_SD][l * 1024 + g * 16 + h];
        float xr = 0.f, xi = 0.f;
        if (!prompt) { xr = F.in[I_S5R][((size_t)(l * NDEC + nseq) * 64 + g) * 64 + p]; xi = F.in[I_S5I][((size_t)(l * NDEC + nseq) * 64 + g) * 64 + p]; }
        const bf16_t* up = F.Z + (size_t)row0 * ZW + ZU + g * 16;
        u32x4 u0 = *(const u32x4*)up, u1 = *(const u32x4*)(up + 8);
        for (int t = 0; t < T; ++t) {
            const u32x4 c0 = u0, c1 = u1;
            const float uh = bf2f(up[(size_t)t * ZW + h]);
            if (t + 1 < T) { u0 = *(const u32x4*)(up + (size_t)(t + 1) * ZW); u1 = *(const u32x4*)(up + (size_t)(t + 1) * ZW + 8); }
            float uu[16];
            uu[0] = bflo(c0.x); uu[1] = bfhi(c0.x); uu[2] = bflo(c0.y); uu[3] = bfhi(c0.y); uu[4] = bflo(c0.z); uu[5] = bfhi(c0.z); uu[6] = bflo(c0.w); uu[7] = bfhi(c0.w);
            uu[8] = bflo(c1.x); uu[9] = bfhi(c1.x); uu[10] = bflo(c1.y); uu[11] = bfhi(c1.y); uu[12] = bflo(c1.z); uu[13] = bfhi(c1.z); uu[14] = bflo(c1.w); uu[15] = bfhi(c1.w);
            float er = 0.f, ei = 0.f;
#pragma unroll
            for (int c = 0; c < 16; ++c) { er += bbr[c] * uu[c]; ei += bbi[c] * uu[c]; }
            const float nxr = ar * xr - ai * xi + er, nxi = ar * xi + ai * xr + ei;
            xr = nxr; xi = nxi;
            sx[p] = (f32x2){xr, xi};
            asm volatile("s_waitcnt lgkmcnt(0)" ::: "memory");
            float ys = 0.f;
#pragma unroll
            for (int c = 0; c < 16; ++c) { const f32x2 xv = sx[q * 16 + c]; ys += cr[c] * xv[0] - ci[c] * xv[1]; }
            asm volatile("s_waitcnt lgkmcnt(0)" ::: "memory");
            ys += __shfl_xor(ys, 16); ys += __shfl_xor(ys, 32);
            if (F.lane < 16) { const float y = ys + dsk * uh; F.ZS5[(size_t)(row0 + t) * 1024 + g * 16 + h] = f2bf(gelu_tanh(y)); }
        }
        if (prompt) { F.out[O_PS5R + ((size_t)(l * NB + nseq) * 64 + g) * 64 + p] = xr; F.out[O_PS5I + ((size_t)(l * NB + nseq) * 64 + g) * 64 + p] = xi; }
        else { F.out[O_SS5R + ((size_t)(l * NDEC + nseq) * 64 + g) * 64 + p] = xr; F.out[O_SS5I + ((size_t)(l * NDEC + nseq) * 64 + g) * 64 + p] = xi; }
    }
}

__device__ __forceinline__ void gla_naive_phase(const Frame& F, int l) {
    const int v = F.lane & 15, dq = F.lane >> 4;
    for (int it = F.wave * F.G + F.bid; it < 36 * 64; it += F.G * NWAVE) {
        int nseq, hd, dv, T, row0; bool prompt;
        if (it < 256) { nseq = it >> 6; hd = (it >> 4) & 3; dv = it & 15; T = TP; row0 = nseq * TP; prompt = true; }
        else { const int j = it - 256; nseq = j >> 6; hd = (j >> 4) & 3; dv = j & 15; T = 1; row0 = ROWS_P + nseq; prompt = false; }
        float S[32];
        float* sout = prompt ? F.out + O_PGLA + (((size_t)(l * NB + nseq) * 4 + hd) * 128 + dq * 32) * 256 + dv * 16 + v
                             : F.out + O_SGLA + (((size_t)(l * NDEC + nseq) * 4 + hd) * 128 + dq * 32) * 256 + dv * 16 + v;
        if (prompt) {
#pragma unroll
            for (int i = 0; i < 32; ++i) S[i] = 0.f; }
        else { const float* sin_ = F.in[I_GLA] + (((size_t)(l * NDEC + nseq) * 4 + hd) * 128 + dq * 32) * 256 + dv * 16 + v;
#pragma unroll
            for (int i = 0; i < 32; ++i) S[i] = sin_[(size_t)i * 256]; }
        const bf16_t* qp = F.Z + (size_t)row0 * ZW + ZQB + hd * 128 + dq * 32;
        const bf16_t* kp = F.Z + (size_t)row0 * ZW + ZKB + hd * 128 + dq * 32;
        const bf16_t* vp = F.Z + (size_t)row0 * ZW + ZVB + hd * 256 + dv * 16 + v;
        const float* dp = F.DEC + (size_t)row0 * 512 + hd * 128 + dq * 32;
        u32x4 qn[4], kn[4]; f32x4 dn[8]; float vn;
#pragma unroll
        for (int c = 0; c < 4; ++c) { qn[c] = *(const u32x4*)(qp + c * 8); kn[c] = *(const u32x4*)(kp + c * 8); }
#pragma unroll
        for (int c = 0; c < 8; ++c) dn[c] = *(const f32x4*)(dp + c * 4);
        vn = bf2f(*vp);
        for (int t = 0; t < T; ++t) {
            u32x4 qc[4], kc[4]; f32x4 dc[8]; const float vv = vn;
#pragma unroll
            for (int c = 0; c < 4; ++c) { qc[c] = qn[c]; kc[c] = kn[c]; }
#pragma unroll
            for (int c = 0; c < 8; ++c) dc[c] = dn[c];
            if (t + 1 < T) { const size_t o = (size_t)(t + 1);
#pragma unroll
                for (int c = 0; c < 4; ++c) { qn[c] = *(const u32x4*)(qp + o * ZW + c * 8); kn[c] = *(const u32x4*)(kp + o * ZW + c * 8); }
#pragma unroll
                for (int c = 0; c < 8; ++c) dn[c] = *(const f32x4*)(dp + o * 512 + c * 4);
                vn = bf2f(vp[o * ZW]); }
            float o_ = 0.f;
#pragma unroll
            for (int c = 0; c < 4; ++c) {
                const unsigned qw[4] = {qc[c].x, qc[c].y, qc[c].z, qc[c].w}, kw[4] = {kc[c].x, kc[c].y, kc[c].z, kc[c].w};
#pragma unroll
                for (int j = 0; j < 4; ++j) { const int i = c * 8 + j * 2;
                    S[i] = dc[i >> 2][i & 3] * S[i] + bflo(kw[j]) * vv; o_ += bflo(qw[j]) * S[i];
                    S[i + 1] = dc[(i + 1) >> 2][(i + 1) & 3] * S[i + 1] + bfhi(kw[j]) * vv; o_ += bfhi(qw[j]) * S[i + 1]; }
            }
            o_ += __shfl_xor(o_, 16); o_ += __shfl_xor(o_, 32);
            if (F.lane < 16) F.GLAO[(size_t)(row0 + t) * 1024 + hd * 256 + dv * 16 + v] = o_;
        }
#pragma unroll
        for (int i = 0; i < 32; ++i) sout[(size_t)i * 256] = S[i];
    }
}
__device__ __forceinline__ void gla_post_phase(const Frame& F, int l) {
    const float* go = F.in[I_GOUT] + l * 256;
    for (int row = F.bid * NWAVE + F.wave; row < MREAL; row += F.G * NWAVE) {
#pragma unroll
        for (int hd = 0; hd < 4; ++hd) {
            const f32x4 o = *(const f32x4*)(F.GLAO + (size_t)row * 1024 + hd * 256 + F.lane * 4);
            float ss = o[0] * o[0] + o[1] * o[1] + o[2] * o[2] + o[3] * o[3];
            ss = wave_sum(ss);
            const float rs = 1.0f / sqrtf(ss * (1.0f / 256.0f) + EPS);
            const f32x4 g = *(const f32x4*)(go + F.lane * 4);
            const u32x2 rr = *(const u32x2*)(F.Z + (size_t)row * ZW + ZRB + hd * 256 + F.lane * 4);
            u32x2 w; w.x = cvt_pk_bf16(o[0] * rs * g[0] * bflo(rr.x), o[1] * rs * g[1] * bfhi(rr.x)); w.y = cvt_pk_bf16(o[2] * rs * g[2] * bflo(rr.y), o[3] * rs * g[3] * bfhi(rr.y));
            *(u32x2*)(F.Y + ((size_t)1 * MP + row) * 1024 + hd * 256 + F.lane * 4) = w;
        }
    }
}

__device__ __forceinline__ float dot64(const u32x4 (&qv)[8], const bf16_t* kp) {
    float s = 0.f;
#pragma unroll
    for (int c = 0; c < 8; ++c) { const u32x4 kv = *(const u32x4*)(kp + c * 8);
        s += bflo(qv[c].x) * bflo(kv.x) + bfhi(qv[c].x) * bfhi(kv.x) + bflo(qv[c].y) * bflo(kv.y) + bfhi(qv[c].y) * bfhi(kv.y)
           + bflo(qv[c].z) * bflo(kv.z) + bfhi(qv[c].z) * bfhi(kv.z) + bflo(qv[c].w) * bflo(kv.w) + bfhi(qv[c].w) * bfhi(kv.w); }
    return s;
}
template <bool PROMPT>
__device__ __forceinline__ void swa_naive_phase(const Frame& F, int l) {
    const float* sinks = F.in[I_SINK] + l * 16;
    if (PROMPT) for (int it = F.bid * NWAVE + F.wave; it < NB * TP * 16; it += F.G * NWAVE) {
        const int qh = it & 15, rt = it >> 4, nseq = rt / TP, t = rt - nseq * TP, kvh = qh >> 2;
        const size_t row = (size_t)nseq * TP + t;
        u32x4 qv[8];
#pragma unroll
        for (int c = 0; c < 8; ++c) qv[c] = *(const u32x4*)(F.Z + row * ZW + ZQC + qh * 64 + c * 8);
        float s[2];
#pragma unroll
        for (int hf = 0; hf < 2; ++hf) { const int idx = F.lane + 64 * hf, kt = t - 127 + idx; const bool valid = kt >= 0;
            const size_t krow = (size_t)nseq * TP + (valid ? kt : 0);
            const float dt_ = dot64(qv, F.Z + krow * ZW + ZKC + kvh * 64);
            s[hf] = valid ? dt_ + F.BIAS[qh * 128 + (127 - idx)] : -INFINITY; }
        const float sk = sinks[qh];
        const float m = fmaxf(wave_max(fmaxf(s[0], s[1])), sk);
        const float p0 = __expf(s[0] - m), p1 = __expf(s[1] - m);
        const float den = wave_sum(p0 + p1) + __expf(sk - m);
        float acc = 0.f;
        const bf16_t* vbase = F.Z + ((size_t)nseq * TP + (t - 127)) * ZW + ZVC + kvh * 64 + F.lane;
        const int i0 = (t >= 127) ? 0 : 127 - t;
        for (int idx = i0; idx < 64; ++idx) { const float pj = __uint_as_float(__builtin_amdgcn_readlane(__float_as_uint(p0), idx)); acc += pj * bf2f(vbase[(ptrdiff_t)idx * ZW]); }
        for (int idx = (i0 > 64 ? i0 : 64); idx < 128; ++idx) { const float pj = __uint_as_float(__builtin_amdgcn_readlane(__float_as_uint(p1), idx - 64)); acc += pj * bf2f(vbase[(ptrdiff_t)idx * ZW]); }
        F.Y[((size_t)2 * MP + row) * 1024 + qh * 64 + F.lane] = f2bf(acc / den);
    }
    for (int it = F.bid * NWAVE + F.wave; it < NDEC * 16; it += F.G * NWAVE) {
        const int qh = it & 15, n = it >> 4, kvh = qh >> 2;
        const size_t row = (size_t)ROWS_P + n;
        const float* ck = F.in[I_CK] + (size_t)(l * NDEC + n) * 128 * 256 + kvh * 64;
        const float* cv = F.in[I_CV] + (size_t)(l * NDEC + n) * 128 * 256 + kvh * 64;
        float qf[64];
#pragma unroll
        for (int c = 0; c < 8; ++c) { const u32x4 qq = *(const u32x4*)(F.Z + row * ZW + ZQC + qh * 64 + c * 8);
            qf[c * 8] = bflo(qq.x); qf[c * 8 + 1] = bfhi(qq.x); qf[c * 8 + 2] = bflo(qq.y); qf[c * 8 + 3] = bfhi(qq.y); qf[c * 8 + 4] = bflo(qq.z); qf[c * 8 + 5] = bfhi(qq.z); qf[c * 8 + 6] = bflo(qq.w); qf[c * 8 + 7] = bfhi(qq.w); }
        float s[2];
#pragma unroll
        for (int hf = 0; hf < 2; ++hf) { const int idx = F.lane + 1 + 64 * hf;
            float dt_ = 0.f;
            if (idx < 128) {
#pragma unroll
                for (int c = 0; c < 16; ++c) { const f32x4 kv = *(const f32x4*)(ck + (size_t)idx * 256 + c * 4); dt_ += qf[c * 4] * kv[0] + qf[c * 4 + 1] * kv[1] + qf[c * 4 + 2] * kv[2] + qf[c * 4 + 3] * kv[3]; }
            } else {
#pragma unroll
                for (int c = 0; c < 64; ++c) dt_ += qf[c] * bf2f(F.Z[row * ZW + ZKC + kvh * 64 + c]);
            }
            s[hf] = dt_ + F.BIAS[qh * 128 + (128 - idx)]; }
        const float sk = sinks[qh];
        const float m = fmaxf(wave_max(fmaxf(s[0], s[1])), sk);
        const float p0 = __expf(s[0] - m), p1 = __expf(s[1] - m);
        const float den = wave_sum(p0 + p1) + __expf(sk - m);
        float acc = 0.f;
        for (int j = 0; j < 64; ++j) { const float pj = __uint_as_float(__builtin_amdgcn_readlane(__float_as_uint(p0), j)); acc += pj * cv[(size_t)(j + 1) * 256 + F.lane]; }
        for (int j = 0; j < 63; ++j) { const float pj = __uint_as_float(__builtin_amdgcn_readlane(__float_as_uint(p1), j)); acc += pj * cv[(size_t)(j + 65) * 256 + F.lane]; }
        { const float pj = __uint_as_float(__builtin_amdgcn_readlane(__float_as_uint(p1), 63)); acc += pj * bf2f(F.Z[row * ZW + ZVC + kvh * 64 + F.lane]); }
        F.Y[((size_t)2 * MP + row) * 1024 + qh * 64 + F.lane] = f2bf(acc / den);
    }
    for (int idx = F.bid * NTHR + F.tid; idx < NB * 128 * 256; idx += F.G * NTHR) {
        const int c = idx & 255, j = (idx >> 8) & 127, b = idx >> 15;
        const size_t row = (size_t)b * TP + (TP - 128) + j;
        F.out[O_PSWK + (size_t)l * NB * 128 * 256 + idx] = bf2f(F.Z[row * ZW + ZKC + c]);
        F.out[O_PSWV + (size_t)l * NB * 128 * 256 + idx] = bf2f(F.Z[row * ZW + ZVC + c]);
    }
    for (int idx = F.bid * NTHR + F.tid; idx < NDEC * 128 * 256; idx += F.G * NTHR) {
        const int c = idx & 255, j = (idx >> 8) & 127, n = idx >> 15;
        const size_t row = (size_t)ROWS_P + n;
        float kv, vv;
        if (j < 127) { kv = F.in[I_CK][(size_t)l * NDEC * 128 * 256 + idx + 256]; vv = F.in[I_CV][(size_t)l * NDEC * 128 * 256 + idx + 256]; }
        else { kv = bf2f(F.Z[row * ZW + ZKC + c]); vv = bf2f(F.Z[row * ZW + ZVC + c]); }
        F.out[O_SSWK + (size_t)l * NDEC * 128 * 256 + idx] = kv;
        F.out[O_SSWV + (size_t)l * NDEC * 128 * 256 + idx] = vv;
    }
}

__device__ __forceinline__ void swa_fast_phase(const Frame& F, int l) {
    LAS float* ext = (LAS float*)F.lds;
    for (int i = F.tid; i < 16 * 192; i += NTHR) { const int hq = i / 192, dd = i - hq * 192 - 32; ext[i] = (dd >= 0 && dd < 128) ? F.BIAS[hq * 128 + dd] : -INFINITY; }
    __syncthreads();
    const int q = F.lane & 31, h = F.lane >> 5;
    for (int it = F.bid * NWAVE + F.wave; it < NB * 65 * 16; it += F.G * NWAVE) {
        const int qh = it & 15, tile = (it >> 4) % 65, b = it / (65 * 16), kvh = qh >> 2, t0 = tile * 32;
        const int tq = (t0 + q < TP) ? t0 + q : TP - 1;
        const size_t rowq = (size_t)b * TP + tq;
        bf16x8 Qf[4];
#pragma unroll
        for (int s = 0; s < 4; ++s) Qf[s] = *(const bf16x8*)(F.Z + rowq * ZW + ZQC + qh * 64 + 16 * s + 8 * h);
        const int kb0 = t0 - 128, blk_lo = (t0 < 128) ? (128 - t0) >> 5 : 0;
        float sc[5][16];
        const LAS float* ex = ext + qh * 192 + (160 + q - 4 * h - 155);
#pragma unroll
        for (int blk = 0; blk < 5; ++blk) {
            if (blk >= blk_lo) {
                const bf16_t* kp = F.Z + ((size_t)b * TP + kb0 + 32 * blk + q) * ZW + ZKC + kvh * 64 + 8 * h;
                f32x16 acc;
#pragma unroll
                for (int r = 0; r < 16; ++r) acc[r] = 0.f;
#pragma unroll
                for (int s = 0; s < 4; ++s) { const bf16x8 Kf = *(const bf16x8*)(kp + 16 * s); acc = __builtin_amdgcn_mfma_f32_32x32x16_bf16(Kf, Qf[s], acc, 0, 0, 0); }
#pragma unroll
                for (int r = 0; r < 16; ++r) sc[blk][r] = acc[r] + ex[155 - (32 * blk + (r & 3) + 8 * (r >> 2))];
            } else {
#pragma unroll
                for (int r = 0; r < 16; ++r) sc[blk][r] = -INFINITY;
            }
        }
        float m = -INFINITY;
#pragma unroll
        for (int blk = 0; blk < 5; ++blk)
#pragma unroll
            for (int r = 0; r < 16; ++r) m = fmaxf(m, sc[blk][r]);
        m = fmaxf(m, __shfl_xor(m, 32));
        const float sk = F.in[I_SINK][l * 16 + qh];
        m = fmaxf(m, sk);
        float sum = 0.f;
#pragma unroll
        for (int blk = 0; blk < 5; ++blk)
#pragma unroll
            for (int r = 0; r < 16; ++r) { const float p = __expf(sc[blk][r] - m); sc[blk][r] = p; sum += p; }
        sum += __shfl_xor(sum, 32);
        const float inv = 1.0f / (sum + __expf(sk - m));
        f32x16 O0, O1;
#pragma unroll
        for (int r = 0; r < 16; ++r) { O0[r] = 0.f; O1[r] = 0.f; }
        const bf16_t* vt0 = F.VT + (size_t)(kvh * 64 + q) * MP + (size_t)b * TP + kb0 + 4 * h;
#pragma unroll
        for (int blk = 0; blk < 5; ++blk) {
            if (blk >= blk_lo) {
#pragma unroll
                for (int s2 = 0; s2 < 2; ++s2) {
                    u32x4 pp; pp.x = pk_bf16(sc[blk][8 * s2 + 0], sc[blk][8 * s2 + 1]); pp.y = pk_bf16(sc[blk][8 * s2 + 2], sc[blk][8 * s2 + 3]);
                    pp.z = pk_bf16(sc[blk][8 * s2 + 4], sc[blk][8 * s2 + 5]); pp.w = pk_bf16(sc[blk][8 * s2 + 6], sc[blk][8 * s2 + 7]);
                    const bf16x8 Pf = __builtin_bit_cast(bf16x8, pp);
                    const bf16_t* vp = vt0 + 32 * blk + 16 * s2;
                    { const u32x2 a0 = *(const u32x2*)vp, a1 = *(const u32x2*)(vp + 8); u32x4 av; av.x = a0.x; av.y = a0.y; av.z = a1.x; av.w = a1.y;
                      O0 = __builtin_amdgcn_mfma_f32_32x32x16_bf16(__builtin_bit_cast(bf16x8, av), Pf, O0, 0, 0, 0); }
                    { const u32x2 a0 = *(const u32x2*)(vp + (size_t)32 * MP), a1 = *(const u32x2*)(vp + (size_t)32 * MP + 8); u32x4 av; av.x = a0.x; av.y = a0.y; av.z = a1.x; av.w = a1.y;
                      O1 = __builtin_amdgcn_mfma_f32_32x32x16_bf16(__builtin_bit_cast(bf16x8, av), Pf, O1, 0, 0, 0); }
                }
            }
        }
        if (t0 + q < TP) {
            bf16_t* yp = F.Y + ((size_t)2 * MP + rowq) * 1024 + qh * 64 + 4 * h;
#pragma unroll
            for (int g4 = 0; g4 < 4; ++g4) {
                u32x2 w0; w0.x = pk_bf16(O0[4 * g4] * inv, O0[4 * g4 + 1] * inv); w0.y = pk_bf16(O0[4 * g4 + 2] * inv, O0[4 * g4 + 3] * inv); *(u32x2*)(yp + 8 * g4) = w0;
                u32x2 w1; w1.x = pk_bf16(O1[4 * g4] * inv, O1[4 * g4 + 1] * inv); w1.y = pk_bf16(O1[4 * g4 + 2] * inv, O1[4 * g4 + 3] * inv); *(u32x2*)(yp + 32 + 8 * g4) = w1;
            }
        }
    }
    __syncthreads();
}

constexpr int NPH = 11, PH_FINAL = 1 + DEPTH * NPH, N_PHASES = PH_FINAL + 1;
#ifndef N_LAUNCH_MODE
#define N_LAUNCH_MODE 1
#endif

__global__ void __launch_bounds__(NTHR, 2) mega(Args a) {
    extern __shared__ __attribute__((aligned(16))) unsigned char lds_raw[];
    Frame F;
    F.in = a.in; F.out = a.out; F.ws = a.ws; F.lds = (LAS unsigned char*)lds_raw;
    F.tid = threadIdx.x; F.lane = F.tid & 63; F.wave = __builtin_amdgcn_readfirstlane(F.tid >> 6); F.G = gridDim.x; F.bid = blockIdx.x;
    unsigned char* ws = a.ws;
    F.Wt_in = (bf16_t*)(ws + WS_WIN); F.Wt_glu = (bf16_t*)(ws + WS_WGLU); F.Wt_up = (bf16_t*)(ws + WS_WUP); F.Wt_out = (bf16_t*)(ws + WS_WOUT); F.Wt_ff1 = (bf16_t*)(ws + WS_WFF1); F.Wt_ff2 = (bf16_t*)(ws + WS_WFF2);
    F.X = (float*)(ws + WS_X); F.H = (bf16_t*)(ws + WS_H); F.AIN = (float*)(ws + WS_AIN); F.Z = (bf16_t*)(ws + WS_Z); F.ZS5 = (bf16_t*)(ws + WS_ZS5); F.Y = (bf16_t*)(ws + WS_Y);
    F.GLAO = (float*)(ws + WS_GLAO); F.DEC = (float*)(ws + WS_DEC); F.MRG = (float*)(ws + WS_MRG); F.MERGED = (bf16_t*)(ws + WS_MERGED); F.MIX = (float*)(ws + WS_MIX); F.FFH = (bf16_t*)(ws + WS_Z);
    F.S5A = (float*)(ws + WS_S5A); F.S5B = (float*)(ws + WS_S5B); F.BIAS = (float*)(ws + WS_BIAS); F.VT = (bf16_t*)(ws + WS_VT);

    LAS unsigned* misc = (LAS unsigned*)(F.lds + LDS_MISC_OFF);
    if (F.tid < 4) misc[F.tid] = 0u;
    __syncthreads();
    const int lo = a.ph_lo, hi = a.ph_hi;
    XcdBarrier bar; bar.bar = (unsigned*)(ws + WS_CTL); bar.x = 0; bar.st = (volatile LAS unsigned*)misc;
    if (hi - lo > 1) bar = xcd_barrier_post((unsigned*)(ws + WS_CTL), (volatile LAS unsigned*)misc);
#ifndef PHMASK
#define PHMASK 0xFFFF
#endif
#define ON(i) (((PHMASK) >> (i)) & 1)
#ifndef REPMASK
#define REPMASK 0
#endif
#define REP(i) for (int rep_ = 0; rep_ < 1 + (((REPMASK) >> (i)) & 1); ++rep_)
#define IN(k) (lo <= (k) && (k) < hi)
#define SEAM(k) do { if (IN(k) && IN((k) + 1)) xcd_barrier(bar); } while (0)

    if (ON(12) && IN(0)) { F.fresh(); prologue_phase(F); }
    SEAM(0);
    for (int l = 0; l < DEPTH; ++l) {
        const int pb = 1 + l * NPH;
#define FRESH() do { if (REPMASK) __syncthreads(); F.fresh(); } while (0)
        if (ON(0) && IN(pb + 0)) REP(0) { FRESH(); if (l == 0) norm_phase<0>(F, 0); else norm_phase<2>(F, l); }
        SEAM(pb + 0);
        if (ON(1) && IN(pb + 1)) REP(1) { FRESH();
            pg8::Gemm g{F.H, F.Wt_in + (size_t)l * ZW * D, MP, ZW, D}; pg8::StaticOrder S; S.init(MP, ZW, F.G, F.bid);
            pg8::EpiIn E{F.Z, ZW, F.VT, MP};
            pg8::gemm_phase<pg8::EpiIn, pg8::StaticOrder>(F.lds, g, S, E, nullptr);
        }
        SEAM(pb + 1);
        if (ON(2) && IN(pb + 2)) REP(2) { FRESH(); gla_pre_phase(F, l); s5_naive_phase(F, l); swa_naive_phase<false>(F, l); __syncthreads(); swa_fast_phase(F, l); }
        SEAM(pb + 2);
        if (ON(3) && IN(pb + 3)) REP(3) { FRESH(); gla_naive_phase(F, l); }
        SEAM(pb + 3);
        if (ON(4) && IN(pb + 4)) REP(4) { FRESH(); gla_post_phase(F, l); }
        SEAM(pb + 4);
        if (ON(5) && IN(pb + 5)) REP(5) { FRESH();
            pg8::Gemm g{F.ZS5, F.Wt_glu + (size_t)l * 1024 * 1024, MP, 1024, 1024}; pg8::StaticOrder S; S.init(MP, 1024, F.G, F.bid);
            pg8::EpiGlu E{F.Y, F.ZS5, F.in[I_BGLU] + l * 1024, 1024};
            pg8::gemm_phase<pg8::EpiGlu, pg8::StaticOrder>(F.lds, g, S, E, nullptr);
        }
        SEAM(pb + 5);
        if (ON(6) && IN(pb + 6)) REP(6) { FRESH();
            pg8::StaticOrder S; S.init(MP, D, F.G, F.bid);
            { pg8::Gemm g{F.Y, F.Wt_up + ((size_t)l * 3 + 0) * D * 1024, MP, D, 1024}; pg8::EpiMerge<0> E{F.MRG, F.MERGED, F.Z + ZG, ZW}; pg8::gemm_phase<pg8::EpiMerge<0>, pg8::StaticOrder>(F.lds, g, S, E, nullptr); }
            { pg8::Gemm g{F.Y + (size_t)MP * 1024, F.Wt_up + ((size_t)l * 3 + 1) * D * 1024, MP, D, 1024}; pg8::EpiMerge<1> E{F.MRG, F.MERGED, F.Z + ZG + 2048, ZW}; pg8::gemm_phase<pg8::EpiMerge<1>, pg8::StaticOrder>(F.lds, g, S, E, nullptr); }
            { pg8::Gemm g{F.Y + (size_t)2 * MP * 1024, F.Wt_up + ((size_t)l * 3 + 2) * D * 1024, MP, D, 1024}; pg8::EpiMerge<2> E{F.MRG, F.MERGED, F.Z + ZG + 4096, ZW}; pg8::gemm_phase<pg8::EpiMerge<2>, pg8::StaticOrder>(F.lds, g, S, E, nullptr); }
        }
        SEAM(pb + 6);
        if (ON(7) && IN(pb + 7)) REP(7) { FRESH();
            pg8::Gemm g{F.MERGED, F.Wt_out + (size_t)l * D * D, MP, D, D}; pg8::StaticOrder S; S.init(MP, D, F.G, F.bid);
            pg8::EpiF32 E{F.MIX, D};
            pg8::gemm_phase<pg8::EpiF32, pg8::StaticOrder>(F.lds, g, S, E, nullptr);
        }
        SEAM(pb + 7);
        if (ON(8) && IN(pb + 8)) REP(8) { FRESH(); norm_phase<1>(F, l); }
        SEAM(pb + 8);
        if (ON(9) && IN(pb + 9)) REP(9) { FRESH();
            pg8::Gemm g{F.H, F.Wt_ff1 + (size_t)l * DFF * D, MP, DFF, D}; pg8::StaticOrder S; S.init(MP, DFF, F.G, F.bid);
            pg8::EpiFF1 E{F.FFH, DFF};
            pg8::gemm_phase<pg8::EpiFF1, pg8::StaticOrder>(F.lds, g, S, E, nullptr);
        }
        SEAM(pb + 9);
        if (ON(10) && IN(pb + 10)) REP(10) { FRESH();
            pg8::Gemm g{F.FFH, F.Wt_ff2 + (size_t)l * D * DFF, MP, D, DFF}; pg8::StaticOrder S; S.init(MP, D, F.G, F.bid);
            pg8::EpiF32 E{F.MIX, D};
            pg8::gemm_phase<pg8::EpiF32, pg8::StaticOrder>(F.lds, g, S, E, nullptr);
        }
        SEAM(pb + 10);
    }
    if (ON(11) && IN(PH_FINAL)) { F.fresh(); norm_phase<3>(F, DEPTH); }
#undef IN
#undef SEAM
}

extern "C" void kernel_launch(void* const* d_in, const int* in_sizes, int n_in, void* d_out, int out_size, void* d_ws, size_t ws_size, hipStream_t stream) {
    static int grid = 0;
    if (grid == 0) {
        if (n_in != N_IN || (size_t)out_size != O_END || ws_size < WS_END) {
            fprintf(stderr, "kernel_launch: expected %d inputs, %zu outputs, >= %zu bytes of workspace; got %d, %d, %zu; nothing launched\n", (int)N_IN, (size_t)O_END, (size_t)WS_END, n_in, out_size, ws_size); grid = -1; return; }
        int dev = 0, cus = 0, per_cu = 0;
        if (hipGetDevice(&dev) != hipSuccess || hipDeviceGetAttribute(&cus, hipDeviceAttributeMultiprocessorCount, dev) != hipSuccess) { fprintf(stderr, "kernel_launch: device query failed\n"); grid = -1; return; }
        if (hipFuncSetAttribute((const void*)mega, hipFuncAttributeMaxDynamicSharedMemorySize, LDS_BYTES) != hipSuccess) { fprintf(stderr, "kernel_launch: hipFuncSetAttribute failed\n"); grid = -1; return; }
        if (hipOccupancyMaxActiveBlocksPerMultiprocessor(&per_cu, (const void*)mega, NTHR, LDS_BYTES) != hipSuccess || per_cu < 1) { fprintf(stderr, "kernel_launch: occupancy query says %d blocks per CU\n", per_cu); }
        (void)hipGetLastError();
        grid = cus;
        if (grid > 256) grid = 256;
    }
    if (grid < 0) return;
    if (hipMemsetAsync((char*)d_ws + WS_CTL, 0, WS_CTL_BYTES, stream) != hipSuccess) { fprintf(stderr, "kernel_launch: memset failed\n"); return; }
    Args a{};
    for (int i = 0; i < N_IN; ++i) a.in[i] = (const float*)d_in[i];
    a.out = (float*)d_out; a.ws = (unsigned char*)d_ws;
#if N_LAUNCH_MODE == 1
    a.ph_lo = 0; a.ph_hi = N_PHASES;
    hipLaunchKernelGGL(mega, dim3(grid), dim3(NTHR), LDS_BYTES, stream, a);
#else
    for (int ph = 0; ph < N_PHASES; ++ph) { a.ph_lo = ph; a.ph_hi = ph + 1; hipLaunchKernelGGL(mega, dim3(grid), dim3(NTHR), LDS_BYTES, stream, a); }
#endif
    const hipError_t le = hipPeekAtLastError();
    if (le != hipSuccess) fprintf(stderr, "kernel_launch: launch failed: %s\n", hipGetErrorName(le));
}
```

```cpp
#include <hip/hip_runtime.h>
#include <cstdio>
#include <cstdint>
#include <cstddef>

#define LAS __attribute__((address_space(3)))
typedef unsigned short bf16_t;
typedef short bf16x8 __attribute__((ext_vector_type(8)));
typedef float f32x4 __attribute__((ext_vector_type(4)));
typedef float f32x2 __attribute__((ext_vector_type(2)));
typedef unsigned u32x4 __attribute__((ext_vector_type(4)));
typedef unsigned u32x2 __attribute__((ext_vector_type(2)));

constexpr int D = 2048, NB = 4, SEQ = 2048, NMETA = 16, TP = SEQ + NMETA, NDEC = 32, DEPTH = 4;
constexpr int ROWS_P = NB * TP;
constexpr int MREAL = ROWS_P + NDEC;
constexpr int MP = 8448;
constexpr int INW = 11792, ZW = 11776;
constexpr int ZU = 0, ZQB = 1024, ZKB = 1536, ZVB = 2048, ZRB = 3072, ZQC = 4096, ZKC = 5120, ZVC = 5376, ZG = 5632;
constexpr int DFF = 8192;
constexpr float EPS = 1e-6f;

enum { I_XP = 0, I_XS, I_S5R, I_S5I, I_GLA, I_CK, I_CV, I_META, I_RELB, I_NPM, I_NQM, I_NPF, I_NQF, I_WIN, I_LRE, I_LIM, I_LSTEP, I_BRE, I_BIM, I_CRE, I_CIM, I_SD, I_WGLU, I_BGLU,
       I_WG2, I_BG2, I_GOUT, I_SINK, I_WUS5, I_WUGLA, I_WUSWA, I_WOUT, I_WFF1, I_WFF2, N_IN };

constexpr size_t O_YP = 0, O_YS = O_YP + (size_t)NB * SEQ * D, O_PS5R = O_YS + (size_t)NDEC * D, O_PS5I = O_PS5R + (size_t)DEPTH * NB * 4096,
                 O_PGLA = O_PS5I + (size_t)DEPTH * NB * 4096, O_PSWK = O_PGLA + (size_t)DEPTH * NB * 4 * 128 * 256, O_PSWV = O_PSWK + (size_t)DEPTH * NB * 128 * 256,
                 O_SS5R = O_PSWV + (size_t)DEPTH * NB * 128 * 256, O_SS5I = O_SS5R + (size_t)DEPTH * NDEC * 4096, O_SGLA = O_SS5I + (size_t)DEPTH * NDEC * 4096,
                 O_SSWK = O_SGLA + (size_t)DEPTH * NDEC * 4 * 128 * 256, O_SSWV = O_SSWK + (size_t)DEPTH * NDEC * 128 * 256, O_END = O_SSWV + (size_t)DEPTH * NDEC * 128 * 256;

constexpr size_t al256(size_t x) { return (x + 255) & ~(size_t)255; }
constexpr size_t WS_CTL = 0, WS_CTL_BYTES = 65536;
constexpr size_t WS_WIN = WS_CTL + WS_CTL_BYTES;
constexpr size_t WS_WGLU = WS_WIN + (size_t)DEPTH * ZW * D * 2;
constexpr size_t WS_WUP = WS_WGLU + (size_t)DEPTH * 1024 * 1024 * 2;
constexpr size_t WS_WOUT = WS_WUP + (size_t)DEPTH * 3 * 2048 * 1024 * 2;
constexpr size_t WS_WFF1 = WS_WOUT + (size_t)DEPTH * 2048 * 2048 * 2;
constexpr size_t WS_WFF2 = WS_WFF1 + (size_t)DEPTH * DFF * D * 2;
constexpr size_t WS_X = WS_WFF2 + (size_t)DEPTH * DFF * D * 2;
constexpr size_t WS_H = WS_X + (size_t)MP * D * 4;
constexpr size_t WS_AIN = WS_H + (size_t)MP * D * 2;
constexpr size_t WS_Z = WS_AIN + (size_t)MP * 16 * 4;
constexpr size_t WS_ZS5 = WS_Z + (size_t)MP * ZW * 2;
constexpr size_t WS_Y = WS_ZS5 + (size_t)MP * 1024 * 2;
constexpr size_t WS_GLAO = WS_Y + (size_t)3 * MP * 1024 * 2;
constexpr size_t WS_DEC = WS_GLAO + (size_t)MP * 1024 * 4;
constexpr size_t WS_MRG = WS_DEC + (size_t)MP * 512 * 4;
constexpr size_t WS_MERGED = WS_MRG + (size_t)MP * D * 4;
constexpr size_t WS_MIX = WS_MERGED + (size_t)MP * D * 2;
constexpr size_t WS_S5A = WS_MIX + (size_t)MP * D * 4;
constexpr size_t WS_S5B = WS_S5A + (size_t)DEPTH * 4096 * 2 * 4;
constexpr size_t WS_BIAS = WS_S5B + (size_t)DEPTH * 4096 * 32 * 4;
constexpr size_t WS_VT = WS_BIAS + 16 * 128 * 4;
constexpr size_t WS_W1T = WS_VT + (size_t)256 * MP * 2;
constexpr size_t WS_W2T = WS_W1T + (size_t)DEPTH * 64 * 128 * 256 * 2;
constexpr size_t WS_KLAG = WS_W2T + (size_t)DEPTH * 64 * 16 * 16 * 128 * 2;
constexpr size_t WS_A16 = WS_KLAG + al256((size_t)DEPTH * 64 * 17 * 256 * 2);
constexpr size_t WS_END = WS_A16 + (size_t)DEPTH * 4096 * 2 * 4;

__device__ __forceinline__ unsigned cvt_pk_bf16(float lo, float hi) { unsigned r; asm volatile("v_cvt_pk_bf16_f32 %0, %1, %2" : "=v"(r) : "v"(lo), "v"(hi)); return r; }
typedef __bf16 bf16x2v __attribute__((ext_vector_type(2)));
typedef float f32x16 __attribute__((ext_vector_type(16)));
__device__ __forceinline__ unsigned pk_bf16(float a, float b) { const f32x2 v = {a, b}; const bf16x2v r = __builtin_convertvector(v, bf16x2v); return __builtin_bit_cast(unsigned, r); }
__device__ __forceinline__ bf16_t f2bf(float f) { return (bf16_t)(cvt_pk_bf16(f, 0.f) & 0xffffu); }
__device__ __forceinline__ float bf2f(bf16_t b) { return __uint_as_float(((unsigned)b) << 16); }
__device__ __forceinline__ float bflo(unsigned u) { return __uint_as_float(u << 16); }
__device__ __forceinline__ float bfhi(unsigned u) { return __uint_as_float(u & 0xffff0000u); }
__device__ __forceinline__ float wave_sum(float v) {
#pragma unroll
    for (int o = 32; o >= 1; o >>= 1) v += __shfl_xor(v, o);
    return v; }
__device__ __forceinline__ float wave_max(float v) {
#pragma unroll
    for (int o = 32; o >= 1; o >>= 1) v = fmaxf(v, __shfl_xor(v, o));
    return v; }
__device__ __forceinline__ float sigmoidf_(float x) { return 1.0f / (1.0f + __expf(-x)); }
__device__ __forceinline__ float gelu_tanh(float y) { const float a = 0.7978845608028654f * (y + 0.044715f * y * y * y); const float e = __expf(2.0f * a); const float th = 1.0f - 2.0f / (e + 1.0f); return 0.5f * y * (1.0f + th); }

#define XB_TMO      128
#define XB_XCNT(j)  (256  + 64 * (j))
#define XB_XSUB(j)  (1280 + 64 * (j))
#define XB_XGEN(j)  (2304 + 64 * (j))
#define XB_TOP      3328
#define XB_TOPGEN   3392
#define XCD_BAR_WORDS 3456
#define XB_SPIN_CAP (1u << 18)

__device__ __forceinline__ unsigned xb_ld(unsigned* p)              { return __hip_atomic_load(p, __ATOMIC_RELAXED, __HIP_MEMORY_SCOPE_AGENT); }
__device__ __forceinline__ unsigned xb_add(unsigned* p, unsigned v) { return __hip_atomic_fetch_add(p, v, __ATOMIC_RELAXED, __HIP_MEMORY_SCOPE_AGENT); }
__device__ __forceinline__ unsigned xb_xcc_id() { return (unsigned)__builtin_amdgcn_s_getreg((3 << 11) | 20) & 0xFu; }
#define XB_SPIN(cond, bar) do { unsigned _sp = 0; while (cond) { __builtin_amdgcn_s_sleep(1); \
    if ((++_sp & 255u) == 0u) { if (xb_ld(&(bar)[XB_TMO])) break; if (_sp > XB_SPIN_CAP) { atomicAdd(&(bar)[XB_TMO], 1u); break; } } } } while (0)

struct XcdBarrier {
    unsigned* bar; unsigned x;
    volatile LAS unsigned* st;
};

__device__ __forceinline__ XcdBarrier xcd_barrier_post(unsigned* bar, volatile LAS unsigned* st) {
    XcdBarrier b; b.bar = bar; b.x = xb_xcc_id(); b.st = st;
    if (threadIdx.x == 0) (void)xb_add(&bar[XB_XCNT(b.x)], 1u);
    return b;
}
__device__ __forceinline__ void xcd_barrier_complete(unsigned* bar, unsigned x, unsigned& nloc, unsigned& nx) {
    const unsigned G = gridDim.x * gridDim.y * gridDim.z;
    unsigned sum, cnt, mine, sp = 0u;
    for (;;) {
        sum = 0u; cnt = 0u; mine = 0u;
#pragma unroll
        for (unsigned j = 0; j < 16; ++j) { const unsigned c = xb_ld(&bar[XB_XCNT(j)]); sum += c; cnt += (c > 0u) ? 1u : 0u; mine = (j == x) ? c : mine; }
        if (sum == G) break;
        __builtin_amdgcn_s_sleep(1);
        if ((++sp & 255u) == 0u) { if (xb_ld(&bar[XB_TMO])) break; if (sp > XB_SPIN_CAP) { atomicAdd(&bar[XB_TMO], 1u); break; } }
    }
    nloc = mine > 0u ? mine : 1u; nx = cnt > 0u ? cnt : 1u;
}

__device__ __forceinline__ void xcd_barrier(const XcdBarrier& b) {
    asm volatile("s_waitcnt vmcnt(0)" ::: "memory");
    __syncthreads();
    if (threadIdx.x == 0) {
        unsigned* bar = b.bar;
        __builtin_amdgcn_s_waitcnt(0);
        unsigned nloc = b.st[0], nx = b.st[1];
        if (nloc == 0u) { xcd_barrier_complete(bar, b.x, nloc, nx); b.st[0] = nloc; b.st[1] = nx; }
        const unsigned old = xb_add(&bar[XB_XSUB(b.x)], 1u);
        const unsigned gen = old / nloc;
        if (old + 1u == (gen + 1u) * nloc) {
            __builtin_amdgcn_fence(__ATOMIC_RELEASE, "agent");
            asm volatile("s_waitcnt vmcnt(0)" ::: "memory");
            const unsigned og = xb_add(&bar[XB_TOP], 1u);
            const unsigned tg = og / nx;
            if (og + 1u == (tg + 1u) * nx) xb_add(&bar[XB_TOPGEN], 1u);
            else XB_SPIN(xb_ld(&bar[XB_TOPGEN]) == tg, bar);
            __builtin_amdgcn_fence(__ATOMIC_ACQUIRE, "agent");
            xb_add(&bar[XB_XGEN(b.x)], 1u);
            asm volatile("s_waitcnt vmcnt(0)" ::: "memory");
        } else {
            XB_SPIN(xb_ld(&bar[XB_XGEN(b.x)]) == gen, bar);
            __builtin_amdgcn_fence(__ATOMIC_ACQUIRE, "agent");
            asm volatile("s_waitcnt vmcnt(0)" ::: "memory");
        }
    }
    __syncthreads();
}

namespace pg8 {
#define PG8_LAS __attribute__((address_space(3)))
typedef unsigned short bf16_t;
typedef short bf16x8 __attribute__((ext_vector_type(8)));
typedef float f32x4 __attribute__((ext_vector_type(4)));
typedef unsigned u32x4 __attribute__((ext_vector_type(4)));
constexpr int BM = 256, BK = 64, HALF = 128, HTB = HALF * BK * 2  , STAGE_BYTES = 8 * HTB, NXCD = 8, WGM = 8;

__host__ __device__ __forceinline__ int lds_byte(int r, int c) { const int st = (r >> 4) * 2 + (c >> 5), rr = r & 15, cc = c & 31, ob = rr * 64 + cc * 2; return st * 1024 + (ob ^ (((ob >> 9) & 1) << 5)); }
__host__ __device__ __forceinline__ void stage_rc(int b, int& R, int& C) { const int st = b / 1024, sb = b % 1024, swz = sb ^ (((sb >> 9) & 1) << 5); R = (st >> 1) * 16 + swz / 64; C = (st & 1) * 32 + (swz % 64) / 2; }
__host__ __device__ __forceinline__ int perm32(int rho) { const int n = rho >> 4, i = rho & 15; return 8 * (i >> 2) + 4 * n + (i & 3); }

struct Unit { int pm, pn; };
struct Gemm { const bf16_t* A; const bf16_t* Bt; int M, N, K; };

struct StaticOrder {
    int nM, nN, nwg, G, c;
    __host__ __device__ void init(int M, int N, int G_, int c_) { nM = M / BM; nN = N / BM; nwg = nM * nN; G = G_; c = c_; }
    __host__ __device__ bool next(int i, Unit& u) const {
        const long L = (long)i * G + c; if (L >= nwg) return false;
        int wgid = (int)L; { const int q = nwg / NXCD, r = nwg % NXCD, xcd = wgid % NXCD, off = wgid / NXCD; wgid = (xcd < r ? xcd * (q + 1) : r * (q + 1) + (xcd - r) * q) + off; }
        const int nig = WGM * nN, gid = wgid / nig, fm = gid * WGM, gsz = (nM - fm) < WGM ? (nM - fm) : WGM;
        u.pm = fm + ((wgid % nig) % gsz); u.pn = (wgid % nig) / gsz; return true;
    }
    __device__ __forceinline__ void a_ready(const Unit&) const {}
    __device__ __forceinline__ void done(const Unit&) const {}
};

__device__ __forceinline__ unsigned cvt_pk_bf16(float lo, float hi) { unsigned r; asm volatile("v_cvt_pk_bf16_f32 %0, %1, %2" : "=v"(r) : "v"(lo), "v"(hi)); return r; }
__device__ __forceinline__ float sigm(float x) { return 1.0f / (1.0f + __expf(-x)); }

struct EpiF32 {
    static constexpr bool PERM = false, AFTER_DRAIN = false;
    float* C; int ldc;
    __device__ __forceinline__ void operator()(const f32x4 (&acc)[2][2][4][2], const Unit& u, int wr, int wc, int fr, int fq) const {
        const int row0 = u.pm * BM + wr * 64 + fr, col0 = u.pn * BM + wc * 32 + 4 * fq;
#pragma unroll
        for (int ai = 0; ai < 2; ++ai)
#pragma unroll
            for (int m = 0; m < 4; ++m) { float* rowp = C + (size_t)(row0 + ai * HALF + m * 16) * ldc + col0;
#pragma unroll
                for (int bj = 0; bj < 2; ++bj)
#pragma unroll
                    for (int n = 0; n < 2; ++n) *(f32x4*)(rowp + bj * HALF + n * 16) = acc[ai][bj][m][n]; }
    }
};
struct EpiIn {
    static constexpr bool PERM = true, AFTER_DRAIN = false;
    bf16_t* O; int ldc; bf16_t* VT; int ldvt;
    __device__ __forceinline__ void operator()(const f32x4 (&acc)[2][2][4][2], const Unit& u, int wr, int wc, int fr, int fq) const {
        const int row0 = u.pm * BM + wr * 64 + fr, col0 = u.pn * BM + wc * 32 + 8 * fq;
        const int pn = u.pn;
        const int act = (pn >= 22) ? 1 : ((pn >= 12 && pn < 16) ? 2 : ((pn == 4 || pn == 5 || (pn >= 16 && pn < 20)) ? 3 : 0));
        const float sc = (pn == 4 || pn == 5) ? 0.08838834764831845f : 0.125f;
#pragma unroll
        for (int ai = 0; ai < 2; ++ai)
#pragma unroll
            for (int m = 0; m < 4; ++m) { bf16_t* rowp = O + (size_t)(row0 + ai * HALF + m * 16) * ldc + col0;
#pragma unroll
                for (int bj = 0; bj < 2; ++bj) { f32x4 v0 = acc[ai][bj][m][0], v1 = acc[ai][bj][m][1];
                    if (act == 1) {
#pragma unroll
                        for (int j = 0; j < 4; ++j) { v0[j] = sigm(v0[j]); v1[j] = sigm(v1[j]); } }
                    else if (act == 2) {
#pragma unroll
                        for (int j = 0; j < 4; ++j) { v0[j] = v0[j] * sigm(v0[j]); v1[j] = v1[j] * sigm(v1[j]); } }
                    else if (act == 3) { v0 = v0 * sc; v1 = v1 * sc; }
                    u32x4 w; w.x = cvt_pk_bf16(v0[0], v0[1]); w.y = cvt_pk_bf16(v0[2], v0[3]); w.z = cvt_pk_bf16(v1[0], v1[1]); w.w = cvt_pk_bf16(v1[2], v1[3]);
                    *(u32x4*)(rowp + bj * HALF) = w;
                    if (pn == 21) { bf16_t* vt = VT + (size_t)(wc * 32 + 8 * fq + bj * HALF) * ldvt + (row0 + ai * HALF + m * 16);
                        vt[0] = (bf16_t)(w.x & 0xffffu); vt[(size_t)ldvt] = (bf16_t)(w.x >> 16); vt[(size_t)2 * ldvt] = (bf16_t)(w.y & 0xffffu); vt[(size_t)3 * ldvt] = (bf16_t)(w.y >> 16);
                        vt[(size_t)4 * ldvt] = (bf16_t)(w.z & 0xffffu); vt[(size_t)5 * ldvt] = (bf16_t)(w.z >> 16); vt[(size_t)6 * ldvt] = (bf16_t)(w.w & 0xffffu); vt[(size_t)7 * ldvt] = (bf16_t)(w.w >> 16); } } }
    }
};
struct EpiFF1 {
    static constexpr bool PERM = true, AFTER_DRAIN = false;
    bf16_t* O; int ldc;
    __device__ __forceinline__ void operator()(const f32x4 (&acc)[2][2][4][2], const Unit& u, int wr, int wc, int fr, int fq) const {
        const int row0 = u.pm * BM + wr * 64 + fr, col0 = u.pn * BM + wc * 32 + 8 * fq;
#pragma unroll
        for (int ai = 0; ai < 2; ++ai)
#pragma unroll
            for (int m = 0; m < 4; ++m) { bf16_t* rowp = O + (size_t)(row0 + ai * HALF + m * 16) * ldc + col0;
#pragma unroll
                for (int bj = 0; bj < 2; ++bj) { f32x4 v0 = acc[ai][bj][m][0], v1 = acc[ai][bj][m][1];
#pragma unroll
                    for (int j = 0; j < 4; ++j) { const float a = fmaxf(v0[j], 0.f), b = fmaxf(v1[j], 0.f); v0[j] = a * a; v1[j] = b * b; }
                    u32x4 w; w.x = cvt_pk_bf16(v0[0], v0[1]); w.y = cvt_pk_bf16(v0[2], v0[3]); w.z = cvt_pk_bf16(v1[0], v1[1]); w.w = cvt_pk_bf16(v1[2], v1[3]);
                    *(u32x4*)(rowp + bj * HALF) = w; } }
    }
};
struct EpiGlu {
    static constexpr bool PERM = true, AFTER_DRAIN = false;
    bf16_t* O; const bf16_t* Zs; const float* bias; int ldc;
    __device__ __forceinline__ void operator()(const f32x4 (&acc)[2][2][4][2], const Unit& u, int wr, int wc, int fr, int fq) const {
        const int row0 = u.pm * BM + wr * 64 + fr, col0 = u.pn * BM + wc * 32 + 8 * fq;
        f32x4 bv[2][2];
#pragma unroll
        for (int bj = 0; bj < 2; ++bj)
#pragma unroll
            for (int n = 0; n < 2; ++n) bv[bj][n] = *(const f32x4*)(bias + col0 + bj * HALF + 4 * n);
#pragma unroll
        for (int ai = 0; ai < 2; ++ai)
#pragma unroll
            for (int m = 0; m < 4; ++m) { const size_t ro = (size_t)(row0 + ai * HALF + m * 16) * ldc + col0;
#pragma unroll
                for (int bj = 0; bj < 2; ++bj) { f32x4 v0 = acc[ai][bj][m][0] + bv[bj][0], v1 = acc[ai][bj][m][1] + bv[bj][1];
                    const u32x4 zz = *(const u32x4*)(Zs + ro + bj * HALF);
                    const float z0 = __uint_as_float(zz.x << 16), z1 = __uint_as_float(zz.x & 0xffff0000u), z2 = __uint_as_float(zz.y << 16), z3 = __uint_as_float(zz.y & 0xffff0000u);
                    const float z4 = __uint_as_float(zz.z << 16), z5 = __uint_as_float(zz.z & 0xffff0000u), z6 = __uint_as_float(zz.w << 16), z7 = __uint_as_float(zz.w & 0xffff0000u);
                    u32x4 w; w.x = cvt_pk_bf16(z0 * sigm(v0[0]), z1 * sigm(v0[1])); w.y = cvt_pk_bf16(z2 * sigm(v0[2]), z3 * sigm(v0[3]));
                    w.z = cvt_pk_bf16(z4 * sigm(v1[0]), z5 * sigm(v1[1])); w.w = cvt_pk_bf16(z6 * sigm(v1[2]), z7 * sigm(v1[3]));
                    *(u32x4*)(O + ro + bj * HALF) = w; } }
    }
};
template <int KB> struct EpiMerge {
    static constexpr bool PERM = false, AFTER_DRAIN = false;
    float* mrg; bf16_t* out; const bf16_t* gate; int ldg;
    __device__ __forceinline__ void operator()(const f32x4 (&acc)[2][2][4][2], const Unit& u, int wr, int wc, int fr, int fq) const {
        const int row0 = u.pm * BM + wr * 64 + fr, col0 = u.pn * BM + wc * 32 + 4 * fq;
#pragma unroll
        for (int ai = 0; ai < 2; ++ai)
#pragma unroll
            for (int m = 0; m < 4; ++m) { const size_t r = (size_t)(row0 + ai * HALF + m * 16);
#pragma unroll
                for (int bj = 0; bj < 2; ++bj)
#pragma unroll
                    for (int n = 0; n < 2; ++n) { const int c = col0 + bj * HALF + n * 16;
                        const u32x2 gg = *(const u32x2*)(gate + r * ldg + c);
                        f32x4 gv; gv[0] = __uint_as_float(gg.x << 16); gv[1] = __uint_as_float(gg.x & 0xffff0000u); gv[2] = __uint_as_float(gg.y << 16); gv[3] = __uint_as_float(gg.y & 0xffff0000u);
                        f32x4 v = gv * acc[ai][bj][m][n];
                        if (KB >= 1) v = v + *(const f32x4*)(mrg + r * 2048 + c);
                        if (KB <= 1) *(f32x4*)(mrg + r * 2048 + c) = v;
                        else { u32x2 w; w.x = cvt_pk_bf16(v[0], v[1]); w.y = cvt_pk_bf16(v[2], v[3]); *(u32x2*)(out + r * 2048 + c) = w; } }
                asm volatile("" ::: "memory"); }
    }
};

template <class Epi, class Sched, bool STAMP = false>
__device__ __forceinline__ void gemm_phase(PG8_LAS unsigned char* lds, const Gemm g, const Sched& S, const Epi& E, unsigned long long* stamps) {
    int tid_ = threadIdx.x; asm volatile("" : "+v"(tid_)); const int tid = tid_, wid = __builtin_amdgcn_readfirstlane(tid >> 6), lane = tid & 63, wr = wid >> 2, wc = wid & 3, fr = lane & 15, fq = lane >> 4;
    const int K = g.K, nt = K / BK;
    int ts_lo = 0, ts_hi = 0, nts = 0; const unsigned long long rt_entry = STAMP ? (unsigned long long)wall_clock64() : 0ull;
#define PG8_STAMP() do { if (STAMP && wid == 0 && nts < 64) { const unsigned long long _c = (unsigned long long)clock64(); \
        ts_lo = (lane == nts) ? (int)(unsigned)_c : ts_lo; ts_hi = (lane == nts) ? (int)(unsigned)(_c >> 32) : ts_hi; ++nts; } } while (0)
    PG8_STAMP();
    unsigned voffA[2], voffB[2];
#pragma unroll
    for (int i = 0; i < 2; ++i) { int R, C; stage_rc(tid * 16 + i * 8192, R, C); const int Rb = Epi::PERM ? ((R & ~31) + perm32(R & 31)) : R;
        voffA[i] = (unsigned)(R * K + C) * 2u; voffB[i] = (unsigned)(Rb * K + C) * 2u; }
    const size_t kstep = (size_t)(BK * 2);
    const size_t hstep = (size_t)HALF * K * 2;
    const size_t tstep = 2 * hstep;
    const unsigned ldsw = (unsigned)wid * 1024u;
    const int aoff = lds_byte(wr * 64 + fr, fq * 8), boff = lds_byte(wc * 32 + fr, fq * 8);
#define PG8_SA(b, h) (((b) * 2 + (h)) * HTB)
#define PG8_SB(b, h) ((4 + (b) * 2 + (h)) * HTB)
#define PG8_STAGE(bufoff, gbase, voff) do { _Pragma("unroll") for (int _i = 0; _i < 2; ++_i) \
        __builtin_amdgcn_global_load_lds((const unsigned*)((const char*)(gbase) + (voff)[_i]), (PG8_LAS unsigned*)(lds + (bufoff) + ldsw + _i * 8192), 16, 0, 0); } while (0)
#define PG8_LDA(dst, b, h) do { _Pragma("unroll") for (int m = 0; m < 4; ++m) _Pragma("unroll") for (int k = 0; k < 2; ++k) dst[m][k] = *(const PG8_LAS bf16x8*)(lds + PG8_SA(b, h) + aoff + m * 2048 + k * 1024); } while (0)
#define PG8_LDB(dst, b, h) do { _Pragma("unroll") for (int n = 0; n < 2; ++n) _Pragma("unroll") for (int k = 0; k < 2; ++k) dst[n][k] = *(const PG8_LAS bf16x8*)(lds + PG8_SB(b, h) + boff + n * 2048 + k * 1024); } while (0)
#define PG8_MMA(ai, bj, At, Bt) do { __builtin_amdgcn_s_setprio(1); _Pragma("unroll") for (int m = 0; m < 4; ++m) _Pragma("unroll") for (int n = 0; n < 2; ++n) _Pragma("unroll") for (int k = 0; k < 2; ++k) \
        acc[ai][bj][m][n] = __builtin_amdgcn_mfma_f32_16x16x32_bf16(Bt[n][k], At[m][k], acc[ai][bj][m][n], 0, 0, 0); __builtin_amdgcn_s_setprio(0); } while (0)
#define PG8_WAIT_V(n) asm volatile("s_waitcnt vmcnt(" #n ")" ::: "memory")
#define PG8_WAIT_L(n) asm volatile("s_waitcnt lgkmcnt(" #n ")" ::: "memory")
#define PG8_BAR __builtin_amdgcn_s_barrier()
#define PG8_SCHED __builtin_amdgcn_sched_barrier(0)
    Unit cur, nxt; int ui = 0;
    if (!S.next(0, cur)) return;
    f32x4 acc[2][2][4][2];
#pragma unroll
    for (int a = 0; a < 2; ++a)
#pragma unroll
        for (int b = 0; b < 2; ++b)
#pragma unroll
            for (int m = 0; m < 4; ++m)
#pragma unroll
                for (int n = 0; n < 2; ++n) acc[a][b][m][n] = (f32x4){0.f, 0.f, 0.f, 0.f};
    bf16x8 At[4][2], B0[2][2], B1[2][2];
    const char* cA = (const char*)g.A + (size_t)cur.pm * tstep; const char* cB = (const char*)g.Bt + (size_t)cur.pn * tstep;
    S.a_ready(cur);
    PG8_STAGE(PG8_SB(0, 0), cB, voffB); PG8_STAGE(PG8_SA(0, 0), cA, voffA); PG8_STAGE(PG8_SB(0, 1), cB + hstep, voffB); PG8_STAGE(PG8_SA(0, 1), cA + hstep, voffA);
    if (wr == 1) PG8_BAR;
    PG8_WAIT_V(4); PG8_BAR;
    PG8_STAGE(PG8_SB(1, 0), cB + kstep, voffB); PG8_STAGE(PG8_SA(1, 0), cA + kstep, voffA); PG8_STAGE(PG8_SB(1, 1), cB + hstep + kstep, voffB);
    PG8_WAIT_V(6); PG8_BAR;
    PG8_STAMP();
    for (;;) {
        const bool has_next = S.next(ui + 1, nxt);
        const char* nA = has_next ? (const char*)g.A + (size_t)nxt.pm * tstep : cA; const char* nB = has_next ? (const char*)g.Bt + (size_t)nxt.pn * tstep : cB;
        for (int t = 0; t < nt; t += 2) {
            const bool last = (t == nt - 2);
            const char* a1 = cA + (size_t)(t + 1) * kstep;
            const char* a2 = last ? nA : cA + (size_t)(t + 2) * kstep; const char* b2 = last ? nB : cB + (size_t)(t + 2) * kstep;
            const char* a3 = a2 + kstep; const char* b3 = b2 + kstep;
            if (last && has_next) S.a_ready(nxt);
            PG8_LDB(B0, 0, 0); PG8_SCHED; PG8_LDA(At, 0, 0); PG8_STAGE(PG8_SA(1, 1), a1 + hstep, voffA);
            PG8_WAIT_L(8); PG8_BAR; PG8_WAIT_L(0); PG8_MMA(0, 0, At, B0); PG8_BAR; PG8_SCHED;
            PG8_LDB(B1, 0, 1); PG8_STAGE(PG8_SB(0, 0), b2, voffB);
            PG8_BAR; PG8_WAIT_L(0); PG8_MMA(0, 1, At, B1); PG8_BAR;
            PG8_LDA(At, 0, 1); PG8_STAGE(PG8_SA(0, 0), a2, voffA);
            PG8_BAR; PG8_WAIT_L(0); PG8_MMA(1, 0, At, B0); PG8_BAR; PG8_SCHED;
            PG8_STAGE(PG8_SB(0, 1), b2 + hstep, voffB);
            PG8_WAIT_V(6); PG8_BAR; PG8_MMA(1, 1, At, B1); PG8_BAR;
            PG8_LDB(B0, 1, 0); PG8_SCHED; PG8_LDA(At, 1, 0); PG8_STAGE(PG8_SA(0, 1), a2 + hstep, voffA);
            PG8_WAIT_L(8); PG8_BAR; PG8_WAIT_L(0); PG8_MMA(0, 0, At, B0); PG8_BAR; PG8_SCHED;
            PG8_LDB(B1, 1, 1); PG8_STAGE(PG8_SB(1, 0), b3, voffB);
            PG8_BAR; PG8_WAIT_L(0); PG8_MMA(0, 1, At, B1); PG8_BAR;
            PG8_LDA(At, 1, 1); PG8_STAGE(PG8_SA(1, 0), a3, voffA);
            PG8_BAR; PG8_WAIT_L(0); PG8_MMA(1, 0, At, B0); PG8_BAR; PG8_SCHED;
            PG8_STAGE(PG8_SB(1, 1), b3 + hstep, voffB);
            PG8_WAIT_V(6); PG8_BAR; PG8_MMA(1, 1, At, B1); PG8_BAR;
        }
        PG8_STAMP();
        if constexpr (!Epi::AFTER_DRAIN) { E(acc, cur, wr, wc, fr, fq); S.done(cur); }
        PG8_STAMP();
        if (!has_next) break;
#pragma unroll
        for (int a = 0; a < 2; ++a)
#pragma unroll
            for (int b = 0; b < 2; ++b)
#pragma unroll
                for (int m = 0; m < 4; ++m)
#pragma unroll
                    for (int n = 0; n < 2; ++n) acc[a][b][m][n] = (f32x4){0.f, 0.f, 0.f, 0.f};
        cur = nxt; cA = nA; cB = nB; ++ui;
    }
    PG8_WAIT_V(0);
    if (wr == 0) PG8_BAR;
    PG8_BAR;
    if constexpr (Epi::AFTER_DRAIN) { E.fused(acc, cur, wr, wc, fr, fq, lds, wid, lane); S.done(cur); }
    PG8_STAMP();
    if (STAMP && wid == 0) { stamps[lane] = lane < nts ? (((unsigned long long)(unsigned)ts_hi << 32) | (unsigned)ts_lo) : 0ull;
        if (lane == 62) stamps[62] = rt_entry; if (lane == 63) stamps[63] = (unsigned long long)wall_clock64(); }
#undef PG8_STAMP
#undef PG8_SA
#undef PG8_SB
#undef PG8_STAGE
#undef PG8_LDA
#undef PG8_LDB
#undef PG8_MMA
#undef PG8_WAIT_V
#undef PG8_WAIT_L
#undef PG8_BAR
#undef PG8_SCHED
}
}

constexpr int NTHR = 512, NWAVE = 8;
constexpr int LDS_STAGE = 131072, LDS_MISC_OFF = LDS_STAGE, LDS_BYTES = LDS_STAGE + 4096;

struct Args { const float* in[N_IN]; float* out; unsigned char* ws; int ph_lo, ph_hi; };

struct Frame {
    const float* const* in; float* out; unsigned char* ws; LAS unsigned char* lds;
    int tid, lane, wave, G, bid;
    __device__ __forceinline__ void fresh() { int t = threadIdx.x; asm volatile("" : "+v"(t)); tid = t; lane = t & 63; wave = __builtin_amdgcn_readfirstlane(t >> 6); int b = blockIdx.x; asm volatile("" : "+s"(b)); bid = b; }
    bf16_t *Wt_in, *Wt_glu, *Wt_up, *Wt_out, *Wt_ff1, *Wt_ff2;
    float* X; bf16_t* H; float* AIN; bf16_t* Z; bf16_t* ZS5; bf16_t* Y; float* GLAO; float* DEC; float* MRG; bf16_t* MERGED; float* MIX; bf16_t* FFH;
    float* S5A; float* S5B; float* BIAS; bf16_t* VT; bf16_t* W1T; bf16_t* W2T; bf16_t* KLAG; float* A16;
};

__device__ __forceinline__ void transpose_convert(const Frame& F, const float* __restrict__ src, bf16_t* __restrict__ dst, int K, int ld, int N, bool is_in) {
    const int ntn = N / 64, ntiles = ntn * (K / 64);
    for (int tile = F.bid * NWAVE + F.wave; tile < ntiles; tile += F.G * NWAVE) {
        const int kt = tile / ntn, nt = tile - kt * ntn, n0 = nt * 64, k0 = kt * 64;
        int sc = n0 + F.lane; if (is_in && sc >= 3072) sc += 16;
        const float* sp = src + (size_t)k0 * ld + sc;
        float v[64];
#pragma unroll
        for (int i = 0; i < 64; ++i) v[i] = sp[(size_t)i * ld];
        u32x4* dp = (u32x4*)(dst + (size_t)(n0 + F.lane) * K + k0);
#pragma unroll
        for (int j = 0; j < 8; ++j) { u32x4 w; w.x = cvt_pk_bf16(v[8 * j], v[8 * j + 1]); w.y = cvt_pk_bf16(v[8 * j + 2], v[8 * j + 3]); w.z = cvt_pk_bf16(v[8 * j + 4], v[8 * j + 5]); w.w = cvt_pk_bf16(v[8 * j + 6], v[8 * j + 7]); dp[j] = w; }
    }
}
__device__ __forceinline__ void prologue_phase(const Frame& F) {
    for (int l = 0; l < DEPTH; ++l) {
        transpose_convert(F, F.in[I_WIN] + (size_t)l * D * INW, F.Wt_in + (size_t)l * ZW * D, D, INW, ZW, true);
        transpose_convert(F, F.in[I_WGLU] + (size_t)l * 1024 * 1024, F.Wt_glu + (size_t)l * 1024 * 1024, 1024, 1024, 1024, false);
        transpose_convert(F, F.in[I_WUS5] + (size_t)l * 1024 * D, F.Wt_up + ((size_t)l * 3 + 0) * D * 1024, 1024, D, D, false);
        transpose_convert(F, F.in[I_WUGLA] + (size_t)l * 1024 * D, F.Wt_up + ((size_t)l * 3 + 1) * D * 1024, 1024, D, D, false);
        transpose_convert(F, F.in[I_WUSWA] + (size_t)l * 1024 * D, F.Wt_up + ((size_t)l * 3 + 2) * D * 1024, 1024, D, D, false);
        transpose_convert(F, F.in[I_WOUT] + (size_t)l * D * D, F.Wt_out + (size_t)l * D * D, D, D, D, false);
        transpose_convert(F, F.in[I_WFF1] + (size_t)l * D * DFF, F.Wt_ff1 + (size_t)l * DFF * D, D, DFF, DFF, false);
        transpose_convert(F, F.in[I_WFF2] + (size_t)l * DFF * D, F.Wt_ff2 + (size_t)l * D * DFF, DFF, D, D, false);
    }
    for (int idx = F.bid * NTHR + F.tid; idx < DEPTH * 4096; idx += F.G * NTHR) {
        const int l = idx >> 12, g = (idx >> 6) & 63;
        const double dt = exp((double)F.in[I_LSTEP][l * 64 + g]);
        const double lr = (double)F.in[I_LRE][idx], li = (double)F.in[I_LIM][idx];
        const double mag = exp(lr * dt), ar = mag * cos(li * dt), ai = mag * sin(li * dt);
        const double den = lr * lr + li * li;
        const double fr = ((ar - 1.0) * lr + ai * li) / den, fi = (ai * lr - (ar - 1.0) * li) / den;
        F.S5A[idx * 2 + 0] = (float)ar; F.S5A[idx * 2 + 1] = (float)ai;
        const float* br = F.in[I_BRE] + (size_t)idx * 16; const float* bi = F.in[I_BIM] + (size_t)idx * 16;
        float* o = F.S5B + (size_t)idx * 32;
#pragma unroll
        for (int h = 0; h < 16; ++h) { const double b_r = br[h], b_i = bi[h]; o[h] = (float)(fr * b_r - fi * b_i); o[16 + h] = (float)(fr * b_i + fi * b_r); }
    }
    for (int idx = F.bid * NTHR + F.tid; idx < DEPTH * 4096; idx += F.G * NTHR) {
        const int l = idx >> 12, g = (idx >> 6) & 63, p = idx & 63;
        const double dt = exp((double)F.in[I_LSTEP][l * 64 + g]);
        const double lr = (double)F.in[I_LRE][idx], li = (double)F.in[I_LIM][idx];
        const double mag = exp(lr * dt), ar = mag * cos(li * dt), ai = mag * sin(li * dt);
        const double den = lr * lr + li * li;
        const double fr = ((ar - 1.0) * lr + ai * li) / den, fi = (ai * lr - (ar - 1.0) * li) / den;
        const float* br = F.in[I_BRE] + (size_t)idx * 16; const float* bi = F.in[I_BIM] + (size_t)idx * 16;
        bf16_t* w1 = F.W1T + (size_t)(l * 64 + g) * 128 * 256;
        double pr = 1.0, pi = 0.0;
        for (int k = 0; k < 16; ++k) { const int s = 15 - k;
            unsigned wr_[8], wi_[8];
#pragma unroll
            for (int h2 = 0; h2 < 8; ++h2) {
                const double b0r = fr * br[2 * h2] - fi * bi[2 * h2], b0i = fr * bi[2 * h2] + fi * br[2 * h2], b1r = fr * br[2 * h2 + 1] - fi * bi[2 * h2 + 1], b1i = fr * bi[2 * h2 + 1] + fi * br[2 * h2 + 1];
                wr_[h2] = pk_bf16((float)(pr * b0r - pi * b0i), (float)(pr * b1r - pi * b1i)); wi_[h2] = pk_bf16((float)(pr * b0i + pi * b0r), (float)(pr * b1i + pi * b1r)); }
            u32x4* d0 = (u32x4*)(w1 + ((size_t)p * 16 + s) * 16); u32x4* d1 = (u32x4*)(w1 + ((size_t)(64 + p) * 16 + s) * 16);
            d0[0] = (u32x4){wr_[0], wr_[1], wr_[2], wr_[3]}; d0[1] = (u32x4){wr_[4], wr_[5], wr_[6], wr_[7]};
            d1[0] = (u32x4){wi_[0], wi_[1], wi_[2], wi_[3]}; d1[1] = (u32x4){wi_[4], wi_[5], wi_[6], wi_[7]};
            const double nr = pr * ar - pi * ai, ni = pr * ai + pi * ar; pr = nr; pi = ni; }
        F.A16[idx * 2] = (float)pr; F.A16[idx * 2 + 1] = (float)pi;
        bf16_t* w2 = F.W2T + (size_t)(l * 64 + g) * 16 * 16 * 128;
        double qr = ar, qi = ai;
        for (int t = 0; t < 16; ++t) {
            for (int h = 0; h < 16; ++h) { const double cr = F.in[I_CRE][((size_t)(l * 64 + g) * 16 + h) * 64 + p], ci = F.in[I_CIM][((size_t)(l * 64 + g) * 16 + h) * 64 + p];
                w2[((size_t)t * 16 + h) * 128 + p] = f2bf((float)(cr * qr - ci * qi)); w2[((size_t)t * 16 + h) * 128 + 64 + p] = f2bf((float)(-(cr * qi + ci * qr))); }
            const double nr = qr * ar - qi * ai, ni = qr * ai + qi * ar; qr = nr; qi = ni; }
    }
    for (int idx = F.bid * NTHR + F.tid; idx < DEPTH * 64 * 256; idx += F.G * NTHR) {
        const int l = idx >> 14, g = (idx >> 8) & 63, h = (idx >> 4) & 15, hp = idx & 15;
        const double dt = exp((double)F.in[I_LSTEP][l * 64 + g]);
        double acc[16];
#pragma unroll
        for (int t = 0; t < 16; ++t) acc[t] = 0.0;
        for (int p = 0; p < 64; ++p) { const int gi = (l * 64 + g) * 64 + p;
            const double lr = (double)F.in[I_LRE][gi], li = (double)F.in[I_LIM][gi];
            const double mag = exp(lr * dt), ar = mag * cos(li * dt), ai = mag * sin(li * dt);
            const double den = lr * lr + li * li;
            const double fr = ((ar - 1.0) * lr + ai * li) / den, fi = (ai * lr - (ar - 1.0) * li) / den;
            const double b_r = F.in[I_BRE][(size_t)gi * 16 + hp], b_i = F.in[I_BIM][(size_t)gi * 16 + hp];
            const double bbr = fr * b_r - fi * b_i, bbi = fr * b_i + fi * b_r;
            const double cr = F.in[I_CRE][((size_t)(l * 64 + g) * 16 + h) * 64 + p], ci = F.in[I_CIM][((size_t)(l * 64 + g) * 16 + h) * 64 + p];
            double vr = cr * bbr - ci * bbi, vi = cr * bbi + ci * bbr;
#pragma unroll
            for (int t = 0; t < 16; ++t) { acc[t] += vr; const double nr = vr * ar - vi * ai, ni = vr * ai + vi * ar; vr = nr; vi = ni; } }
        bf16_t* kl = F.KLAG + (size_t)(l * 64 + g) * 17 * 256;
        kl[h * 16 + hp] = 0;
#pragma unroll
        for (int t = 0; t < 16; ++t) kl[(t + 1) * 256 + h * 16 + hp] = f2bf((float)acc[t]);
    }
    for (int idx = F.bid * NTHR + F.tid; idx < 16 * 128; idx += F.G * NTHR) {
        const int hq = idx >> 7, d = idx & 127;
        int bucket = d;
        if (d >= 16) { bucket = 16 + (int)(log((double)d / 16.0) / log(8.0) * 16.0); if (bucket > 31) bucket = 31; }
        F.BIAS[idx] = F.in[I_RELB][bucket * 16 + hq];
    }
}

template <int MODE>
__device__ __forceinline__ void norm_phase(const Frame& F, int l) {
    constexpr bool AIN = (MODE == 0 || MODE == 2);
    const float* gA = (MODE == 1) ? F.in[I_NQM] + l * D : (MODE == 2) ? F.in[I_NQF] + (l - 1) * D : F.in[I_NQF] + 3 * D;
    const float* gB = (MODE == 0) ? F.in[I_NPM] : (MODE == 1) ? F.in[I_NPF] + l * D : F.in[I_NPM] + l * D;
    LAS f32x4* WaL = (LAS f32x4*)F.lds;
    if (AIN) {
        const float* wl = F.in[I_WIN] + (size_t)l * D * INW + 3072;
        for (int idx = F.tid; idx < 2048 * 4; idx += NTHR) { const int k = idx >> 2, nq = idx & 3;
            const f32x4 w = *(const f32x4*)(wl + (size_t)k * INW + nq * 4);
            const int kk = k >> 8, ln = (k & 255) >> 2, j = k & 3;
            WaL[((kk * 4 + j) * 4 + nq) * 64 + ln] = w; }
        __syncthreads();
    }
    for (int row = F.bid * NWAVE + F.wave; row < MP; row += F.G * NWAVE) {
        if (row >= MREAL) {
            if (MODE == 0) { const f32x4 z4 = {0.f, 0.f, 0.f, 0.f}; const u32x2 z2 = {0u, 0u};
#pragma unroll
                for (int kk = 0; kk < 8; ++kk) { ((f32x4*)(F.X + (size_t)row * D))[kk * 64 + F.lane] = z4; ((u32x2*)(F.H + (size_t)row * D))[kk * 64 + F.lane] = z2; }
                if (F.lane < 16) F.AIN[row * 16 + F.lane] = 0.f; }
            continue;
        }
        f32x4 xv[8];
        const f32x4* xs;
        if (MODE == 0) {
            if (row < ROWS_P) { const int b = row / TP, t = row - b * TP; xs = (t < NMETA) ? (const f32x4*)(F.in[I_META] + (size_t)t * D) : (const f32x4*)(F.in[I_XP] + ((size_t)b * SEQ + (t - NMETA)) * D); }
            else xs = (const f32x4*)(F.in[I_XS] + (size_t)(row - ROWS_P) * D);
        } else xs = (const f32x4*)(F.X + (size_t)row * D);
#pragma unroll
        for (int kk = 0; kk < 8; ++kk) xv[kk] = xs[kk * 64 + F.lane];
        if (MODE != 0) {
            const f32x4* rs_ = (const f32x4*)(F.MIX + (size_t)row * D);
            f32x4 rv[8]; float ss = 0.f;
#pragma unroll
            for (int kk = 0; kk < 8; ++kk) { rv[kk] = rs_[kk * 64 + F.lane]; ss += rv[kk][0] * rv[kk][0] + rv[kk][1] * rv[kk][1] + rv[kk][2] * rv[kk][2] + rv[kk][3] * rv[kk][3]; }
            ss = wave_sum(ss);
            const float rs = 1.0f / sqrtf(ss * (1.0f / D) + EPS);
#pragma unroll
            for (int kk = 0; kk < 8; ++kk) { const f32x4 ga = ((const f32x4*)gA)[kk * 64 + F.lane]; xv[kk] = xv[kk] + rv[kk] * rs * ga; }
        }
        if (MODE == 3) {
            f32x4* od = nullptr;
            if (row < ROWS_P) { const int b = row / TP, t = row - b * TP; if (t >= NMETA) od = (f32x4*)(F.out + O_YP + ((size_t)b * SEQ + (t - NMETA)) * D); }
            else od = (f32x4*)(F.out + O_YS + (size_t)(row - ROWS_P) * D);
            if (od) {
#pragma unroll
                for (int kk = 0; kk < 8; ++kk) od[kk * 64 + F.lane] = xv[kk]; }
            continue;
        }
#pragma unroll
        for (int kk = 0; kk < 8; ++kk) ((f32x4*)(F.X + (size_t)row * D))[kk * 64 + F.lane] = xv[kk];
        float ss2 = 0.f;
#pragma unroll
        for (int kk = 0; kk < 8; ++kk) ss2 += xv[kk][0] * xv[kk][0] + xv[kk][1] * xv[kk][1] + xv[kk][2] * xv[kk][2] + xv[kk][3] * xv[kk][3];
        ss2 = wave_sum(ss2);
        const float rs2 = 1.0f / sqrtf(ss2 * (1.0f / D) + EPS);
#pragma unroll
        for (int kk = 0; kk < 8; ++kk) { const f32x4 gb = ((const f32x4*)gB)[kk * 64 + F.lane]; xv[kk] = xv[kk] * rs2 * gb;
            u32x2 w; w.x = cvt_pk_bf16(xv[kk][0], xv[kk][1]); w.y = cvt_pk_bf16(xv[kk][2], xv[kk][3]); ((u32x2*)(F.H + (size_t)row * D))[kk * 64 + F.lane] = w; }
        if (AIN) {
            float acc[16];
#pragma unroll
            for (int n = 0; n < 16; ++n) acc[n] = 0.f;
#pragma unroll
            for (int kk = 0; kk < 8; ++kk)
#pragma unroll
                for (int j = 0; j < 4; ++j) { const float hv = xv[kk][j];
#pragma unroll
                    for (int nq = 0; nq < 4; ++nq) { const f32x4 w = WaL[((kk * 4 + j) * 4 + nq) * 64 + F.lane];
                        acc[nq * 4 + 0] += hv * w[0]; acc[nq * 4 + 1] += hv * w[1]; acc[nq * 4 + 2] += hv * w[2]; acc[nq * 4 + 3] += hv * w[3]; } }
#pragma unroll
            for (int n = 0; n < 16; ++n) acc[n] = wave_sum(acc[n]);
            float mine = 0.f;
#pragma unroll
            for (int n = 0; n < 16; ++n) mine = (F.lane == n) ? acc[n] : mine;
            if (F.lane < 16) F.AIN[row * 16 + F.lane] = mine;
        }
    }
    if (AIN) __syncthreads();
}

__device__ __forceinline__ void gla_pre_phase(const Frame& F, int l) {
    const int t = F.tid & 127, sub = F.tid >> 7;
    const float* wg = F.in[I_WG2] + (size_t)l * 16 * 512 + 4 * t;
    f32x4 w[16];
#pragma unroll
    for (int r = 0; r < 16; ++r) w[r] = *(const f32x4*)(wg + r * 512);
    const f32x4 bg = *(const f32x4*)(F.in[I_BG2] + l * 512 + 4 * t);
    for (int row = F.bid * 4 + sub; row < MREAL; row += F.G * 4) {
        f32x4 a[4];
#pragma unroll
        for (int q = 0; q < 4; ++q) a[q] = *(const f32x4*)(F.AIN + row * 16 + q * 4);
        f32x4 pre = bg;
#pragma unroll
        for (int r = 0; r < 16; ++r) pre = pre + w[r] * a[r >> 2][r & 3];
        f32x4 o;
#pragma unroll
        for (int c = 0; c < 4; ++c) { const float x = pre[c]; const float ls = fminf(x, 0.f) - log1pf(expf(-fabsf(x))); o[c] = expf(ls * 0.0625f); }
        *(f32x4*)(F.DEC + (size_t)row * 512 + 4 * t) = o;
    }
}

template <bool PROMPT>
__device__ __forceinline__ void s5_naive_phase(const Frame& F, int l) {
    LAS f32x2* sx = (LAS f32x2*)F.lds + F.wave * 64;
    const int p = F.lane, h = F.lane & 15, q = F.lane >> 4;
    for (int it = (PROMPT ? 0 : 256) + F.bid * NWAVE + F.wave; it < 36 * 64; it += F.G * NWAVE) {
        int g, T, row0, nseq; bool prompt;
        if (it < 256) { nseq = it >> 6; g = it & 63; T = TP; row0 = nseq * TP; prompt = true; }
        else { const int j = it - 256; nseq = j >> 6; g = j & 63; T = 1; row0 = ROWS_P + nseq; prompt = false; }
        const int gi = (l * 64 + g) * 64 + p;
        const float ar = F.S5A[gi * 2], ai = F.S5A[gi * 2 + 1];
        float bbr[16], bbi[16];
#pragma unroll
        for (int c = 0; c < 4; ++c) { const f32x4 a = *(const f32x4*)(F.S5B + (size_t)gi * 32 + c * 4), b = *(const f32x4*)(F.S5B + (size_t)gi * 32 + 16 + c * 4);
            bbr[c * 4] = a[0]; bbr[c * 4 + 1] = a[1]; bbr[c * 4 + 2] = a[2]; bbr[c * 4 + 3] = a[3]; bbi[c * 4] = b[0]; bbi[c * 4 + 1] = b[1]; bbi[c * 4 + 2] = b[2]; bbi[c * 4 + 3] = b[3]; }
        float cr[16], ci[16];
        { const float* crp = F.in[I_CRE] + ((size_t)(l * 64 + g) * 16 + h) * 64 + q * 16; const float* cip = F.in[I_CIM] + ((size_t)(l * 64 + g) * 16 + h) * 64 + q * 16;
#pragma unroll
            for (int c = 0; c < 4; ++c) { const f32x4 a = *(const f32x4*)(crp + c * 4), b = *(const f32x4*)(cip + c * 4);
                cr[c * 4] = a[0]; cr[c * 4 + 1] = a[1]; cr[c * 4 + 2] = a[2]; cr[c * 4 + 3] = a[3]; ci[c * 4] = b[0]; ci[c * 4 + 1] = b[1]; ci[c * 4 + 2] = b[2]; ci[c * 4 + 3] = b[3]; } }
        const float dsk = F.in[I_SD][l * 1024 + g * 16 + h];
        float xr = 0.f, xi = 0.f;
        if (!prompt) { xr = F.in[I_S5R][((size_t)(l * NDEC + nseq) * 64 + g) * 64 + p]; xi = F.in[I_S5I][((size_t)(l * NDEC + nseq) * 64 + g) * 64 + p]; }
        const bf16_t* up = F.Z + (size_t)row0 * ZW + ZU + g * 16;
        u32x4 u0 = *(const u32x4*)up, u1 = *(const u32x4*)(up + 8);
        for (int t = 0; t < T; ++t) {
            const u32x4 c0 = u0, c1 = u1;
            const float uh = bf2f(up[(size_t)t * ZW + h]);
            if (t + 1 < T) { u0 = *(const u32x4*)(up + (size_t)(t + 1) * ZW); u1 = *(const u32x4*)(up + (size_t)(t + 1) * ZW + 8); }
            float uu[16];
            uu[0] = bflo(c0.x); uu[1] = bfhi(c0.x); uu[2] = bflo(c0.y); uu[3] = bfhi(c0.y); uu[4] = bflo(c0.z); uu[5] = bfhi(c0.z); uu[6] = bflo(c0.w); uu[7] = bfhi(c0.w);
            uu[8] = bflo(c1.x); uu[9] = bfhi(c1.x); uu[10] = bflo(c1.y); uu[11] = bfhi(c1.y); uu[12] = bflo(c1.z); uu[13] = bfhi(c1.z); uu[14] = bflo(c1.w); uu[15] = bfhi(c1.w);
            float er = 0.f, ei = 0.f;
#pragma unroll
            for (int c = 0; c < 16; ++c) { er += bbr[c] * uu[c]; ei += bbi[c] * uu[c]; }
            const float nxr = ar * xr - ai * xi + er, nxi = ar * xi + ai * xr + ei;
            xr = nxr; xi = nxi;
            sx[p] = (f32x2){xr, xi};
            asm volatile("s_waitcnt lgkmcnt(0)" ::: "memory");
            float ys = 0.f;
#pragma unroll
            for (int c = 0; c < 16; ++c) { const f32x2 xv = sx[q * 16 + c]; ys += cr[c] * xv[0] - ci[c] * xv[1]; }
            asm volatile("s_waitcnt lgkmcnt(0)" ::: "memory");
            ys += __shfl_xor(ys, 16); ys += __shfl_xor(ys, 32);
            if (F.lane < 16) { const float y = ys + dsk * uh; F.ZS5[(size_t)(row0 + t) * 1024 + g * 16 + h] = f2bf(gelu_tanh(y)); }
        }
        if (prompt) { F.out[O_PS5R + ((size_t)(l * NB + nseq) * 64 + g) * 64 + p] = xr; F.out[O_PS5I + ((size_t)(l * NB + nseq) * 64 + g) * 64 + p] = xi; }
        else { F.out[O_SS5R + ((size_t)(l * NDEC + nseq) * 64 + g) * 64 + p] = xr; F.out[O_SS5I + ((size_t)(l * NDEC + nseq) * 64 + g) * 64 + p] = xi; }
    }
}

__device__ __forceinline__ void gla_naive_phase(const Frame& F, int l) {
    const int v = F.lane & 15, dq = F.lane >> 4;
    for (int it = F.wave * F.G + F.bid; it < 36 * 64; it += F.G * NWAVE) {
        int nseq, hd, dv, T, row0; bool prompt;
        if (it < 256) { nseq = it >> 6; hd = (it >> 4) & 3; dv = it & 15; T = TP; row0 = nseq * TP; prompt = true; }
        else { const int j = it - 256; nseq = j >> 6; hd = (j >> 4) & 3; dv = j & 15; T = 1; row0 = ROWS_P + nseq; prompt = false; }
        float S[32];
        float* sout = prompt ? F.out + O_PGLA + (((size_t)(l * NB + nseq) * 4 + hd) * 128 + dq * 32) * 256 + dv * 16 + v
                             : F.out + O_SGLA + (((size_t)(l * NDEC + nseq) * 4 + hd) * 128 + dq * 32) * 256 + dv * 16 + v;
        if (prompt) {
#pragma unroll
            for (int i = 0; i < 32; ++i) S[i] = 0.f; }
        else { const float* sin_ = F.in[I_GLA] + (((size_t)(l * NDEC + nseq) * 4 + hd) * 128 + dq * 32) * 256 + dv * 16 + v;
#pragma unroll
            for (int i = 0; i < 32; ++i) S[i] = sin_[(size_t)i * 256]; }
        const bf16_t* qp = F.Z + (size_t)row0 * ZW + ZQB + hd * 128 + dq * 32;
        const bf16_t* kp = F.Z + (size_t)row0 * ZW + ZKB + hd * 128 + dq * 32;
        const bf16_t* vp = F.Z + (size_t)row0 * ZW + ZVB + hd * 256 + dv * 16 + v;
        const float* dp = F.DEC + (size_t)row0 * 512 + hd * 128 + dq * 32;
        u32x4 qn[4], kn[4]; f32x4 dn[8]; float vn;
#pragma unroll
        for (int c = 0; c < 4; ++c) { qn[c] = *(const u32x4*)(qp + c * 8); kn[c] = *(const u32x4*)(kp + c * 8); }
#pragma unroll
        for (int c = 0; c < 8; ++c) dn[c] = *(const f32x4*)(dp + c * 4);
        vn = bf2f(*vp);
        for (int t = 0; t < T; ++t) {
            u32x4 qc[4], kc[4]; f32x4 dc[8]; const float vv = vn;
#pragma unroll
            for (int c = 0; c < 4; ++c) { qc[c] = qn[c]; kc[c] = kn[c]; }
#pragma unroll
            for (int c = 0; c < 8; ++c) dc[c] = dn[c];
            if (t + 1 < T) { const size_t o = (size_t)(t + 1);
#pragma unroll
                for (int c = 0; c < 4; ++c) { qn[c] = *(const u32x4*)(qp + o * ZW + c * 8); kn[c] = *(const u32x4*)(kp + o * ZW + c * 8); }
#pragma unroll
                for (int c = 0; c < 8; ++c) dn[c] = *(const f32x4*)(dp + o * 512 + c * 4);
                vn = bf2f(vp[o * ZW]); }
            float o_ = 0.f;
#pragma unroll
            for (int c = 0; c < 4; ++c) {
                const unsigned qw[4] = {qc[c].x, qc[c].y, qc[c].z, qc[c].w}, kw[4] = {kc[c].x, kc[c].y, kc[c].z, kc[c].w};
#pragma unroll
                for (int j = 0; j < 4; ++j) { const int i = c * 8 + j * 2;
                    S[i] = dc[i >> 2][i & 3] * S[i] + bflo(kw[j]) * vv; o_ += bflo(qw[j]) * S[i];
                    S[i + 1] = dc[(i + 1) >> 2][(i + 1) & 3] * S[i + 1] + bfhi(kw[j]) * vv; o_ += bfhi(qw[j]) * S[i + 1]; }
            }
            o_ += __shfl_xor(o_, 16); o_ += __shfl_xor(o_, 32);
            if (F.lane < 16) F.GLAO[(size_t)(row0 + t) * 1024 + hd * 256 + dv * 16 + v] = o_;
        }
#pragma unroll
        for (int i = 0; i < 32; ++i) sout[(size_t)i * 256] = S[i];
    }
}
__device__ __forceinline__ void gla_post_phase(const Frame& F, int l) {
    const float* go = F.in[I_GOUT] + l * 256;
    for (int row = F.bid * NWAVE + F.wave; row < MREAL; row += F.G * NWAVE) {
#pragma unroll
        for (int hd = 0; hd < 4; ++hd) {
            const f32x4 o = *(const f32x4*)(F.GLAO + (size_t)row * 1024 + hd * 256 + F.lane * 4);
            float ss = o[0] * o[0] + o[1] * o[1] + o[2] * o[2] + o[3] * o[3];
            ss = wave_sum(ss);
            const float rs = 1.0f / sqrtf(ss * (1.0f / 256.0f) + EPS);
            const f32x4 g = *(const f32x4*)(go + F.lane * 4);
            const u32x2 rr = *(const u32x2*)(F.Z + (size_t)row * ZW + ZRB + hd * 256 + F.lane * 4);
            u32x2 w; w.x = cvt_pk_bf16(o[0] * rs * g[0] * bflo(rr.x), o[1] * rs * g[1] * bfhi(rr.x)); w.y = cvt_pk_bf16(o[2] * rs * g[2] * bflo(rr.y), o[3] * rs * g[3] * bfhi(rr.y));
            *(u32x2*)(F.Y + ((size_t)1 * MP + row) * 1024 + hd * 256 + F.lane * 4) = w;
        }
    }
}

__device__ __forceinline__ float dot64(const u32x4 (&qv)[8], const bf16_t* kp) {
    float s = 0.f;
#pragma unroll
    for (int c = 0; c < 8; ++c) { const u32x4 kv = *(const u32x4*)(kp + c * 8);
        s += bflo(qv[c].x) * bflo(kv.x) + bfhi(qv[c].x) * bfhi(kv.x) + bflo(qv[c].y) * bflo(kv.y) + bfhi(qv[c].y) * bfhi(kv.y)
           + bflo(qv[c].z) * bflo(kv.z) + bfhi(qv[c].z) * bfhi(kv.z) + bflo(qv[c].w) * bflo(kv.w) + bfhi(qv[c].w) * bfhi(kv.w); }
    return s;
}
template <bool PROMPT>
__device__ __forceinline__ void swa_naive_phase(const Frame& F, int l) {
    const float* sinks = F.in[I_SINK] + l * 16;
    if (PROMPT) for (int it = F.bid * NWAVE + F.wave; it < NB * TP * 16; it += F.G * NWAVE) {
        const int qh = it & 15, rt = it >> 4, nseq = rt / TP, t = rt - nseq * TP, kvh = qh >> 2;
        const size_t row = (size_t)nseq * TP + t;
        u32x4 qv[8];
#pragma unroll
        for (int c = 0; c < 8; ++c) qv[c] = *(const u32x4*)(F.Z + row * ZW + ZQC + qh * 64 + c * 8);
        float s[2];
#pragma unroll
        for (int hf = 0; hf < 2; ++hf) { const int idx = F.lane + 64 * hf, kt = t - 127 + idx; const bool valid = kt >= 0;
            const size_t krow = (size_t)nseq * TP + (valid ? kt : 0);
            const float dt_ = dot64(qv, F.Z + krow * ZW + ZKC + kvh * 64);
            s[hf] = valid ? dt_ + F.BIAS[qh * 128 + (127 - idx)] : -INFINITY; }
        const float sk = sinks[qh];
        const float m = fmaxf(wave_max(fmaxf(s[0], s[1])), sk);
        const float p0 = __expf(s[0] - m), p1 = __expf(s[1] - m);
        const float den = wave_sum(p0 + p1) + __expf(sk - m);
        float acc = 0.f;
        const bf16_t* vbase = F.Z + ((size_t)nseq * TP + (t - 127)) * ZW + ZVC + kvh * 64 + F.lane;
        const int i0 = (t >= 127) ? 0 : 127 - t;
        for (int idx = i0; idx < 64; ++idx) { const float pj = __uint_as_float(__builtin_amdgcn_readlane(__float_as_uint(p0), idx)); acc += pj * bf2f(vbase[(ptrdiff_t)idx * ZW]); }
        for (int idx = (i0 > 64 ? i0 : 64); idx < 128; ++idx) { const float pj = __uint_as_float(__builtin_amdgcn_readlane(__float_as_uint(p1), idx - 64)); acc += pj * bf2f(vbase[(ptrdiff_t)idx * ZW]); }
        F.Y[((size_t)2 * MP + row) * 1024 + qh * 64 + F.lane] = f2bf(acc / den);
    }
    for (int it = F.bid * NWAVE + F.wave; it < NDEC * 16; it += F.G * NWAVE) {
        const int qh = it & 15, n = it >> 4, kvh = qh >> 2;
        const size_t row = (size_t)ROWS_P + n;
        const float* ck = F.in[I_CK] + (size_t)(l * NDEC + n) * 128 * 256 + kvh * 64;
        const float* cv = F.in[I_CV] + (size_t)(l * NDEC + n) * 128 * 256 + kvh * 64;
        float qf[64];
#pragma unroll
        for (int c = 0; c < 8; ++c) { const u32x4 qq = *(const u32x4*)(F.Z + row * ZW + ZQC + qh * 64 + c * 8);
            qf[c * 8] = bflo(qq.x); qf[c * 8 + 1] = bfhi(qq.x); qf[c * 8 + 2] = bflo(qq.y); qf[c * 8 + 3] = bfhi(qq.y); qf[c * 8 + 4] = bflo(qq.z); qf[c * 8 + 5] = bfhi(qq.z); qf[c * 8 + 6] = bflo(qq.w); qf[c * 8 + 7] = bfhi(qq.w); }
        float s[2];
#pragma unroll
        for (int hf = 0; hf < 2; ++hf) { const int idx = F.lane + 1 + 64 * hf;
            float dt_ = 0.f;
            if (idx < 128) {
#pragma unroll
                for (int c = 0; c < 16; ++c) { const f32x4 kv = *(const f32x4*)(ck + (size_t)idx * 256 + c * 4); dt_ += qf[c * 4] * kv[0] + qf[c * 4 + 1] * kv[1] + qf[c * 4 + 2] * kv[2] + qf[c * 4 + 3] * kv[3]; }
            } else {
#pragma unroll
                for (int c = 0; c < 64; ++c) dt_ += qf[c] * bf2f(F.Z[row * ZW + ZKC + kvh * 64 + c]);
            }
            s[hf] = dt_ + F.BIAS[qh * 128 + (128 - idx)]; }
        const float sk = sinks[qh];
        const float m = fmaxf(wave_max(fmaxf(s[0], s[1])), sk);
        const float p0 = __expf(s[0] - m), p1 = __expf(s[1] - m);
        const float den = wave_sum(p0 + p1) + __expf(sk - m);
        float acc = 0.f;
        for (int j = 0; j < 64; ++j) { const float pj = __uint_as_float(__builtin_amdgcn_readlane(__float_as_uint(p0), j)); acc += pj * cv[(size_t)(j + 1) * 256 + F.lane]; }
        for (int j = 0; j < 63; ++j) { const float pj = __uint_as_float(__builtin_amdgcn_readlane(__float_as_uint(p1), j)); acc += pj * cv[(size_t)(j + 65) * 256 + F.lane]; }
        { const float pj = __uint_as_float(__builtin_amdgcn_readlane(__float_as_uint(p1), 63)); acc += pj * bf2f(F.Z[row * ZW + ZVC + kvh * 64 + F.lane]); }
        F.Y[((size_t)2 * MP + row) * 1024 + qh * 64 + F.lane] = f2bf(acc / den);
    }
    for (int idx = F.bid * NTHR + F.tid; idx < NB * 128 * 256; idx += F.G * NTHR) {
        const int c = idx & 255, j = (idx >> 8) & 127, b = idx >> 15;
        const size_t row = (size_t)b * TP + (TP - 128) + j;
        F.out[O_PSWK + (size_t)l * NB * 128 * 256 + idx] = bf2f(F.Z[row * ZW + ZKC + c]);
        F.out[O_PSWV + (size_t)l * NB * 128 * 256 + idx] = bf2f(F.Z[row * ZW + ZVC + c]);
    }
    for (int idx = F.bid * NTHR + F.tid; idx < NDEC * 128 * 256; idx += F.G * NTHR) {
        const int c = idx & 255, j = (idx >> 8) & 127, n = idx >> 15;
        const size_t row = (size_t)ROWS_P + n;
        float kv, vv;
        if (j < 127) { kv = F.in[I_CK][(size_t)l * NDEC * 128 * 256 + idx + 256]; vv = F.in[I_CV][(size_t)l * NDEC * 128 * 256 + idx + 256]; }
        else { kv = bf2f(F.Z[row * ZW + ZKC + c]); vv = bf2f(F.Z[row * ZW + ZVC + c]); }
        F.out[O_SSWK + (size_t)l * NDEC * 128 * 256 + idx] = kv;
        F.out[O_SSWV + (size_t)l * NDEC * 128 * 256 + idx] = vv;
    }
}

__device__ __forceinline__ void swa_fast_phase(const Frame& F, int l) {
    LAS float* ext = (LAS float*)F.lds;
    for (int i = F.tid; i < 16 * 192; i += NTHR) { const int hq = i / 192, dd = i - hq * 192 - 32; ext[i] = (dd >= 0 && dd < 128) ? F.BIAS[hq * 128 + dd] : -INFINITY; }
    __syncthreads();
    const int q = F.lane & 31, h = F.lane >> 5;
    for (int it = F.bid * NWAVE + F.wave; it < NB * 65 * 16; it += F.G * NWAVE) {
        const int qh = it & 15, tile = (it >> 4) % 65, b = it / (65 * 16), kvh = qh >> 2, t0 = tile * 32;
        const int tq = (t0 + q < TP) ? t0 + q : TP - 1;
        const size_t rowq = (size_t)b * TP + tq;
        bf16x8 Qf[4];
#pragma unroll
        for (int s = 0; s < 4; ++s) Qf[s] = *(const bf16x8*)(F.Z + rowq * ZW + ZQC + qh * 64 + 16 * s + 8 * h);
        const int kb0 = t0 - 128, blk_lo = (t0 < 128) ? (128 - t0) >> 5 : 0;
        float sc[5][16];
        const LAS float* ex = ext + qh * 192 + (160 + q - 4 * h - 155);
#pragma unroll
        for (int blk = 0; blk < 5; ++blk) {
            if (blk >= blk_lo) {
                const bf16_t* kp = F.Z + ((size_t)b * TP + kb0 + 32 * blk + q) * ZW + ZKC + kvh * 64 + 8 * h;
                f32x16 acc;
#pragma unroll
                for (int r = 0; r < 16; ++r) acc[r] = 0.f;
#pragma unroll
                for (int s = 0; s < 4; ++s) { const bf16x8 Kf = *(const bf16x8*)(kp + 16 * s); acc = __builtin_amdgcn_mfma_f32_32x32x16_bf16(Kf, Qf[s], acc, 0, 0, 0); }
#pragma unroll
                for (int r = 0; r < 16; ++r) sc[blk][r] = acc[r] + ex[155 - (32 * blk + (r & 3) + 8 * (r >> 2))];
            } else {
#pragma unroll
                for (int r = 0; r < 16; ++r) sc[blk][r] = -INFINITY;
            }
        }
        float m = -INFINITY;
#pragma unroll
        for (int blk = 0; blk < 5; ++blk)
#pragma unroll
            for (int r = 0; r < 16; ++r) m = fmaxf(m, sc[blk][r]);
        m = fmaxf(m, __shfl_xor(m, 32));
        const float sk = F.in[I_SINK][l * 16 + qh];
        m = fmaxf(m, sk);
        float sum = 0.f;
#pragma unroll
        for (int blk = 0; blk < 5; ++blk)
#pragma unroll
            for (int r = 0; r < 16; ++r) { const float p = __expf(sc[blk][r] - m); sc[blk][r] = p; sum += p; }
        sum += __shfl_xor(sum, 32);
        const float inv = 1.0f / (sum + __expf(sk - m));
        f32x16 O0, O1;
#pragma unroll
        for (int r = 0; r < 16; ++r) { O0[r] = 0.f; O1[r] = 0.f; }
        const bf16_t* vt0 = F.VT + (size_t)(kvh * 64 + q) * MP + (size_t)b * TP + kb0 + 4 * h;
#pragma unroll
        for (int blk = 0; blk < 5; ++blk) {
            if (blk >= blk_lo) {
#pragma unroll
                for (int s2 = 0; s2 < 2; ++s2) {
                    u32x4 pp; pp.x = pk_bf16(sc[blk][8 * s2 + 0], sc[blk][8 * s2 + 1]); pp.y = pk_bf16(sc[blk][8 * s2 + 2], sc[blk][8 * s2 + 3]);
                    pp.z = pk_bf16(sc[blk][8 * s2 + 4], sc[blk][8 * s2 + 5]); pp.w = pk_bf16(sc[blk][8 * s2 + 6], sc[blk][8 * s2 + 7]);
                    const bf16x8 Pf = __builtin_bit_cast(bf16x8, pp);
                    const bf16_t* vp = vt0 + 32 * blk + 16 * s2;
                    { const u32x2 a0 = *(const u32x2*)vp, a1 = *(const u32x2*)(vp + 8); u32x4 av; av.x = a0.x; av.y = a0.y; av.z = a1.x; av.w = a1.y;
                      O0 = __builtin_amdgcn_mfma_f32_32x32x16_bf16(__builtin_bit_cast(bf16x8, av), Pf, O0, 0, 0, 0); }
                    { const u32x2 a0 = *(const u32x2*)(vp + (size_t)32 * MP), a1 = *(const u32x2*)(vp + (size_t)32 * MP + 8); u32x4 av; av.x = a0.x; av.y = a0.y; av.z = a1.x; av.w = a1.y;
                      O1 = __builtin_amdgcn_mfma_f32_32x32x16_bf16(__builtin_bit_cast(bf16x8, av), Pf, O1, 0, 0, 0); }
                }
            }
        }
        if (t0 + q < TP) {
            bf16_t* yp = F.Y + ((size_t)2 * MP + rowq) * 1024 + qh * 64 + 4 * h;
#pragma unroll
            for (int g4 = 0; g4 < 4; ++g4) {
                u32x2 w0; w0.x = pk_bf16(O0[4 * g4] * inv, O0[4 * g4 + 1] * inv); w0.y = pk_bf16(O0[4 * g4 + 2] * inv, O0[4 * g4 + 3] * inv); *(u32x2*)(yp + 8 * g4) = w0;
                u32x2 w1; w1.x = pk_bf16(O1[4 * g4] * inv, O1[4 * g4 + 1] * inv); w1.y = pk_bf16(O1[4 * g4 + 2] * inv, O1[4 * g4 + 3] * inv); *(u32x2*)(yp + 32 + 8 * g4) = w1;
            }
        }
    }
    __syncthreads();
}

constexpr int S5_SL_STRIDE = 132, S5_XC_STRIDE = 136, S5_XC_OFF = 129 * S5_SL_STRIDE * 4 + 496;
__device__ __forceinline__ void s5_fast_phase(const Frame& F, int l) {
    LAS float* SL = (LAS float*)F.lds;
    LAS bf16_t* XC = (LAS bf16_t*)(F.lds + S5_XC_OFF);
    const int lane = F.lane, w = F.wave, r16 = lane & 15, kg = lane >> 4;
    for (int it = F.bid; it < NB * 64; it += F.G) {
        const int b = it >> 6, g = it & 63;
        const bf16_t* ubase = F.Z + (size_t)b * TP * ZW + ZU + g * 16 + 8 * (kg & 1);
        {
            const bf16_t* w1 = F.W1T + ((size_t)(l * 64 + g) * 128 + 16 * w + r16) * 256 + (kg >> 1) * 16 + 8 * (kg & 1);
            bf16x8 Bf[8];
#pragma unroll
            for (int kk = 0; kk < 8; ++kk) Bf[kk] = *(const bf16x8*)(w1 + 2 * kk * 16);
#pragma unroll 1
            for (int mb = 0; mb < 9; ++mb) {
                int c = 16 * mb + r16; c = c > 128 ? 128 : c;
                const bf16_t* up = ubase + (size_t)(c * 16 + (kg >> 1)) * ZW;
                f32x4 acc = {0.f, 0.f, 0.f, 0.f};
#pragma unroll
                for (int kk = 0; kk < 8; ++kk) { const bf16x8 Af = *(const bf16x8*)(up + (size_t)(2 * kk) * ZW); acc = __builtin_amdgcn_mfma_f32_16x16x32_bf16(Af, Bf[kk], acc, 0, 0, 0); }
#pragma unroll
                for (int r = 0; r < 4; ++r) { const int cc = 16 * mb + 4 * kg + r; if (cc < 129) SL[cc * S5_SL_STRIDE + 16 * w + r16] = acc[r]; }
            }
        }
        __syncthreads();
        if (w == 0) {
            const int gi = (l * 64 + g) * 64 + lane;
            const float a_r = F.A16[gi * 2], a_i = F.A16[gi * 2 + 1];
            float xr = 0.f, xi = 0.f;
            float sr = SL[lane], si = SL[64 + lane];
            for (int c = 0; c < 129; ++c) {
                XC[c * S5_XC_STRIDE + lane] = f2bf(xr); XC[c * S5_XC_STRIDE + 64 + lane] = f2bf(xi);
                const float csr = sr, csi = si;
                if (c + 1 < 129) { sr = SL[(c + 1) * S5_SL_STRIDE + lane]; si = SL[(c + 1) * S5_SL_STRIDE + 64 + lane]; }
                const float nr = a_r * xr - a_i * xi + csr, ni = a_r * xi + a_i * xr + csi; xr = nr; xi = ni;
            }
            F.out[O_PS5R + ((size_t)(l * NB + b) * 64 + g) * 64 + lane] = xr; F.out[O_PS5I + ((size_t)(l * NB + b) * 64 + g) * 64 + lane] = xi;
        } else if (w == 1) {
            for (int i = lane; i < 15 * S5_XC_STRIDE; i += 64) XC[129 * S5_XC_STRIDE + i] = 0;
        }
        __syncthreads();
        {
            const float dsk = F.in[I_SD][l * 1024 + g * 16 + r16];
#pragma unroll 1
            for (int ti = 0; ti < 2; ++ti) {
                const int t = ti ? 15 - w : w;
                f32x4 acc[9];
#pragma unroll
                for (int mb = 0; mb < 9; ++mb) acc[mb] = (f32x4){0.f, 0.f, 0.f, 0.f};
                const bf16_t* kl = F.KLAG + (size_t)(l * 64 + g) * 17 * 256 + r16 * 16 + 8 * (kg & 1);
                const int nkk = (t >> 1) + 1;
#pragma unroll 1
                for (int kk = 0; kk < nkk; ++kk) {
                    const int s = 2 * kk + (kg >> 1);
                    const bf16x8 Bf = *(const bf16x8*)(kl + (t - s + 1) * 256);
#pragma unroll
                    for (int mb = 0; mb < 9; ++mb) { int c = 16 * mb + r16; c = c > 128 ? 128 : c;
                        const bf16x8 Af = *(const bf16x8*)(ubase + (size_t)(c * 16 + s) * ZW);
                        acc[mb] = __builtin_amdgcn_mfma_f32_16x16x32_bf16(Af, Bf, acc[mb], 0, 0, 0); }
                }
                const bf16_t* w2 = F.W2T + (((size_t)(l * 64 + g) * 16 + t) * 16 + r16) * 128 + 8 * kg;
#pragma unroll
                for (int kk = 0; kk < 4; ++kk) {
                    const bf16x8 Bf = *(const bf16x8*)(w2 + 32 * kk);
#pragma unroll
                    for (int mb = 0; mb < 9; ++mb) { const bf16x8 Af = *(const LAS bf16x8*)(XC + (16 * mb + r16) * S5_XC_STRIDE + 32 * kk + 8 * kg);
                        acc[mb] = __builtin_amdgcn_mfma_f32_16x16x32_bf16(Af, Bf, acc[mb], 0, 0, 0); }
                }
#pragma unroll
                for (int mb = 0; mb < 9; ++mb)
#pragma unroll
                    for (int r = 0; r < 4; ++r) { const int cc = 16 * mb + 4 * kg + r;
                        if (cc < 129) { const size_t row = (size_t)b * TP + cc * 16 + t;
                            const float u = bf2f(F.Z[row * ZW + ZU + g * 16 + r16]);
                            F.ZS5[row * 1024 + g * 16 + r16] = f2bf(gelu_tanh(acc[mb][r] + dsk * u)); } }
            }
        }
        __syncthreads();
    }
}

constexpr int NPH = 11, PH_FINAL = 1 + DEPTH * NPH, N_PHASES = PH_FINAL + 1;
#ifndef N_LAUNCH_MODE
#define N_LAUNCH_MODE 1
#endif

__global__ void __launch_bounds__(NTHR, 2) mega(Args a) {
    extern __shared__ __attribute__((aligned(16))) unsigned char lds_raw[];
    Frame F;
    F.in = a.in; F.out = a.out; F.ws = a.ws; F.lds = (LAS unsigned char*)lds_raw;
    F.tid = threadIdx.x; F.lane = F.tid & 63; F.wave = __builtin_amdgcn_readfirstlane(F.tid >> 6); F.G = gridDim.x; F.bid = blockIdx.x;
    unsigned char* ws = a.ws;
    F.Wt_in = (bf16_t*)(ws + WS_WIN); F.Wt_glu = (bf16_t*)(ws + WS_WGLU); F.Wt_up = (bf16_t*)(ws + WS_WUP); F.Wt_out = (bf16_t*)(ws + WS_WOUT); F.Wt_ff1 = (bf16_t*)(ws + WS_WFF1); F.Wt_ff2 = (bf16_t*)(ws + WS_WFF2);
    F.X = (float*)(ws + WS_X); F.H = (bf16_t*)(ws + WS_H); F.AIN = (float*)(ws + WS_AIN); F.Z = (bf16_t*)(ws + WS_Z); F.ZS5 = (bf16_t*)(ws + WS_ZS5); F.Y = (bf16_t*)(ws + WS_Y);
    F.GLAO = (float*)(ws + WS_GLAO); F.DEC = (float*)(ws + WS_DEC); F.MRG = (float*)(ws + WS_MRG); F.MERGED = (bf16_t*)(ws + WS_MERGED); F.MIX = (float*)(ws + WS_MIX); F.FFH = (bf16_t*)(ws + WS_Z);
    F.S5A = (float*)(ws + WS_S5A); F.S5B = (float*)(ws + WS_S5B); F.BIAS = (float*)(ws + WS_BIAS); F.VT = (bf16_t*)(ws + WS_VT); F.W1T = (bf16_t*)(ws + WS_W1T); F.W2T = (bf16_t*)(ws + WS_W2T); F.KLAG = (bf16_t*)(ws + WS_KLAG); F.A16 = (float*)(ws + WS_A16);

    LAS unsigned* misc = (LAS unsigned*)(F.lds + LDS_MISC_OFF);
    if (F.tid < 4) misc[F.tid] = 0u;
    __syncthreads();
    const int lo = a.ph_lo, hi = a.ph_hi;
    XcdBarrier bar; bar.bar = (unsigned*)(ws + WS_CTL); bar.x = 0; bar.st = (volatile LAS unsigned*)misc;
    if (hi - lo > 1) bar = xcd_barrier_post((unsigned*)(ws + WS_CTL), (volatile LAS unsigned*)misc);
#ifndef PHMASK
#define PHMASK 0xFFFF
#endif
#define ON(i) (((PHMASK) >> (i)) & 1)
#ifndef REPMASK
#define REPMASK 0
#endif
#define REP(i) for (int rep_ = 0; rep_ < 1 + (((REPMASK) >> (i)) & 1); ++rep_)
#define IN(k) (lo <= (k) && (k) < hi)
#define SEAM(k) do { if (IN(k) && IN((k) + 1)) xcd_barrier(bar); } while (0)

    if (ON(12) && IN(0)) { F.fresh(); prologue_phase(F); }
    SEAM(0);
    for (int l = 0; l < DEPTH; ++l) {
        const int pb = 1 + l * NPH;
#define FRESH() do { if (REPMASK) __syncthreads(); F.fresh(); } while (0)
        if (ON(0) && IN(pb + 0)) REP(0) { FRESH(); if (l == 0) norm_phase<0>(F, 0); else norm_phase<2>(F, l); }
        SEAM(pb + 0);
        if (ON(1) && IN(pb + 1)) REP(1) { FRESH();
            pg8::Gemm g{F.H, F.Wt_in + (size_t)l * ZW * D, MP, ZW, D}; pg8::StaticOrder S; S.init(MP, ZW, F.G, F.bid);
            pg8::EpiIn E{F.Z, ZW, F.VT, MP};
            pg8::gemm_phase<pg8::EpiIn, pg8::StaticOrder>(F.lds, g, S, E, nullptr);
        }
        SEAM(pb + 1);
        if (ON(2) && IN(pb + 2)) REP(2) { FRESH(); gla_pre_phase(F, l); s5_naive_phase<false>(F, l); swa_naive_phase<false>(F, l); __syncthreads(); s5_fast_phase(F, l); swa_fast_phase(F, l); }
        SEAM(pb + 2);
        if (ON(3) && IN(pb + 3)) REP(3) { FRESH(); gla_naive_phase(F, l); }
        SEAM(pb + 3);
        if (ON(4) && IN(pb + 4)) REP(4) { FRESH(); gla_post_phase(F, l); }
        SEAM(pb + 4);
        if (ON(5) && IN(pb + 5)) REP(5) { FRESH();
            pg8::Gemm g{F.ZS5, F.Wt_glu + (size_t)l * 1024 * 1024, MP, 1024, 1024}; pg8::StaticOrder S; S.init(MP, 1024, F.G, F.bid);
            pg8::EpiGlu E{F.Y, F.ZS5, F.in[I_BGLU] + l * 1024, 1024};
            pg8::gemm_phase<pg8::EpiGlu, pg8::StaticOrder>(F.lds, g, S, E, nullptr);
        }
        SEAM(pb + 5);
        if (ON(6) && IN(pb + 6)) REP(6) { FRESH();
            pg8::StaticOrder S; S.init(MP, D, F.G, F.bid);
            { pg8::Gemm g{F.Y, F.Wt_up + ((size_t)l * 3 + 0) * D * 1024, MP, D, 1024}; pg8::EpiMerge<0> E{F.MRG, F.MERGED, F.Z + ZG, ZW}; pg8::gemm_phase<pg8::EpiMerge<0>, pg8::StaticOrder>(F.lds, g, S, E, nullptr); }
            { pg8::Gemm g{F.Y + (size_t)MP * 1024, F.Wt_up + ((size_t)l * 3 + 1) * D * 1024, MP, D, 1024}; pg8::EpiMerge<1> E{F.MRG, F.MERGED, F.Z + ZG + 2048, ZW}; pg8::gemm_phase<pg8::EpiMerge<1>, pg8::StaticOrder>(F.lds, g, S, E, nullptr); }
            { pg8::Gemm g{F.Y + (size_t)2 * MP * 1024, F.Wt_up + ((size_t)l * 3 + 2) * D * 1024, MP, D, 1024}; pg8::EpiMerge<2> E{F.MRG, F.MERGED, F.Z + ZG + 4096, ZW}; pg8::gemm_phase<pg8::EpiMerge<2>, pg8::StaticOrder>(F.lds, g, S, E, nullptr); }
        }
        SEAM(pb + 6);
        if (ON(7) && IN(pb + 7)) REP(7) { FRESH();
            pg8::Gemm g{F.MERGED, F.Wt_out + (size_t)l * D * D, MP, D, D}; pg8::StaticOrder S; S.init(MP, D, F.G, F.bid);
            pg8::EpiF32 E{F.MIX, D};
            pg8::gemm_phase<pg8::EpiF32, pg8::StaticOrder>(F.lds, g, S, E, nullptr);
        }
        SEAM(pb + 7);
        if (ON(8) && IN(pb + 8)) REP(8) { FRESH(); norm_phase<1>(F, l); }
        SEAM(pb + 8);
        if (ON(9) && IN(pb + 9)) REP(9) { FRESH();
            pg8::Gemm g{F.H, F.Wt_ff1 + (size_t)l * DFF * D, MP, DFF, D}; pg8::StaticOrder S; S.init(MP, DFF, F.G, F.bid);
            pg8::EpiFF1 E{F.FFH, DFF};
            pg8::gemm_phase<pg8::EpiFF1, pg8::StaticOrder>(F.lds, g, S, E, nullptr);
        }
        SEAM(pb + 9);
        if (ON(10) && IN(pb + 10)) REP(10) { FRESH();
            pg8::Gemm g{F.FFH, F.Wt_ff2 + (size_t)l * D * DFF, MP, D, DFF}; pg8::StaticOrder S; S.init(MP, D, F.G, F.bid);
            pg8::EpiF32 E{F.MIX, D};
            pg8::gemm_phase<pg8::EpiF32, pg8::StaticOrder>(F.lds, g, S, E, nullptr);
        }
        SEAM(pb + 10);
    }
    if (ON(11) && IN(PH_FINAL)) { F.fresh(); norm_phase<3>(F, DEPTH); }
#undef IN
#undef SEAM
}

extern "C" void kernel_launch(void* const* d_in, const int* in_sizes, int n_in, void* d_out, int out_size, void* d_ws, size_t ws_size, hipStream_t stream) {
    static int grid = 0;
    if (grid == 0) {
        if (n_in != N_IN || (size_t)out_size != O_END || ws_size < WS_END) {
            fprintf(stderr, "kernel_launch: expected %d inputs, %zu outputs, >= %zu bytes of workspace; got %d, %d, %zu; nothing launched\n", (int)N_IN, (size_t)O_END, (size_t)WS_END, n_in, out_size, ws_size); grid = -1; return; }
        int dev = 0, cus = 0, per_cu = 0;
        if (hipGetDevice(&dev) != hipSuccess || hipDeviceGetAttribute(&cus, hipDeviceAttributeMultiprocessorCount, dev) != hipSuccess) { fprintf(stderr, "kernel_launch: device query failed\n"); grid = -1; return; }
        if (hipFuncSetAttribute((const void*)mega, hipFuncAttributeMaxDynamicSharedMemorySize, LDS_BYTES) != hipSuccess) { fprintf(stderr, "kernel_launch: hipFuncSetAttribute failed\n"); grid = -1; return; }
        if (hipOccupancyMaxActiveBlocksPerMultiprocessor(&per_cu, (const void*)mega, NTHR, LDS_BYTES) != hipSuccess || per_cu < 1) { fprintf(stderr, "kernel_launch: occupancy query says %d blocks per CU\n", per_cu); }
        (void)hipGetLastError();
        grid = cus;
        if (grid > 256) grid = 256;
    }
    if (grid < 0) return;
    if (hipMemsetAsync((char*)d_ws + WS_CTL, 0, WS_CTL_BYTES, stream) != hipSuccess) { fprintf(stderr, "kernel_launch: memset failed\n"); return; }
    Args a{};
    for (int i = 0; i < N_IN; ++i) a.in[i] = (const float*)d_in[i];
    a.out = (float*)d_out; a.ws = (unsigned char*)d_ws;
#if N_LAUNCH_MODE == 1
    a.ph_lo = 0; a.ph_hi = N_PHASES;
    hipLaunchKernelGGL(mega, dim3(grid), dim3(NTHR), LDS_BYTES, stream, a);
#else
    for (int ph = 0; ph < N_PHASES; ++ph) { a.ph_lo = ph; a.ph_hi = ph + 1; hipLaunchKernelGGL(mega, dim3(grid), dim3(NTHR), LDS_BYTES, stream, a); }
#endif
    const hipError_t le = hipPeekAtLastError();
    if (le != hipSuccess) fprintf(stderr, "kernel_launch: launch failed: %s\n", hipGetErrorName(le));
}
```

```cpp
#include <hip/hip_runtime.h>
#include <cstdio>
#include <cstdint>
#include <cstddef>

#define LAS __attribute__((address_space(3)))
typedef unsigned short bf16_t;
typedef short bf16x8 __attribute__((ext_vector_type(8)));
typedef float f32x4 __attribute__((ext_vector_type(4)));
typedef float f32x2 __attribute__((ext_vector_type(2)));
typedef unsigned u32x4 __attribute__((ext_vector_type(4)));
typedef unsigned u32x2 __attribute__((ext_vector_type(2)));

constexpr int D = 2048, NB = 4, SEQ = 2048, NMETA = 16, TP = SEQ + NMETA, NDEC = 32, DEPTH = 4;
constexpr int ROWS_P = NB * TP;
constexpr int MREAL = ROWS_P + NDEC;
constexpr int MP = 8448;
constexpr int INW = 11792, ZW = 11776;
constexpr int ZU = 0, ZQB = 1024, ZKB = 1536, ZVB = 2048, ZRB = 3072, ZQC = 4096, ZKC = 5120, ZVC = 5376, ZG = 5632;
constexpr int DFF = 8192;
constexpr float EPS = 1e-6f;

enum { I_XP = 0, I_XS, I_S5R, I_S5I, I_GLA, I_CK, I_CV, I_META, I_RELB, I_NPM, I_NQM, I_NPF, I_NQF, I_WIN, I_LRE, I_LIM, I_LSTEP, I_BRE, I_BIM, I_CRE, I_CIM, I_SD, I_WGLU, I_BGLU,
       I_WG2, I_BG2, I_GOUT, I_SINK, I_WUS5, I_WUGLA, I_WUSWA, I_WOUT, I_WFF1, I_WFF2, N_IN };

constexpr size_t O_YP = 0, O_YS = O_YP + (size_t)NB * SEQ * D, O_PS5R = O_YS + (size_t)NDEC * D, O_PS5I = O_PS5R + (size_t)DEPTH * NB * 4096,
                 O_PGLA = O_PS5I + (size_t)DEPTH * NB * 4096, O_PSWK = O_PGLA + (size_t)DEPTH * NB * 4 * 128 * 256, O_PSWV = O_PSWK + (size_t)DEPTH * NB * 128 * 256,
                 O_SS5R = O_PSWV + (size_t)DEPTH * NB * 128 * 256, O_SS5I = O_SS5R + (size_t)DEPTH * NDEC * 4096, O_SGLA = O_SS5I + (size_t)DEPTH * NDEC * 4096,
                 O_SSWK = O_SGLA + (size_t)DEPTH * NDEC * 4 * 128 * 256, O_SSWV = O_SSWK + (size_t)DEPTH * NDEC * 128 * 256, O_END = O_SSWV + (size_t)DEPTH * NDEC * 128 * 256;

constexpr size_t al256(size_t x) { return (x + 255) & ~(size_t)255; }
constexpr size_t WS_CTL = 0, WS_CTL_BYTES = 65536;
constexpr size_t WS_WIN = WS_CTL + WS_CTL_BYTES;
constexpr size_t WS_WGLU = WS_WIN + (size_t)DEPTH * ZW * D * 2;
constexpr size_t WS_WUP = WS_WGLU + (size_t)DEPTH * 1024 * 1024 * 2;
constexpr size_t WS_WOUT = WS_WUP + (size_t)DEPTH * 3 * 2048 * 1024 * 2;
constexpr size_t WS_WFF1 = WS_WOUT + (size_t)DEPTH * 2048 * 2048 * 2;
constexpr size_t WS_WFF2 = WS_WFF1 + (size_t)DEPTH * DFF * D * 2;
constexpr size_t WS_X = WS_WFF2 + (size_t)DEPTH * DFF * D * 2;
constexpr size_t WS_H = WS_X + (size_t)MP * D * 4;
constexpr size_t WS_AIN = WS_H + (size_t)MP * D * 2;
constexpr size_t WS_Z = WS_AIN + (size_t)MP * 16 * 4;
constexpr size_t WS_ZS5 = WS_Z + (size_t)MP * ZW * 2;
constexpr size_t WS_Y = WS_ZS5 + (size_t)MP * 1024 * 2;
constexpr size_t WS_GLAO = WS_Y + (size_t)3 * MP * 1024 * 2;
constexpr size_t WS_DEC = WS_GLAO + (size_t)MP * 1024 * 4;
constexpr size_t WS_MRG = WS_DEC + (size_t)MP * 512 * 4;
constexpr size_t WS_MERGED = WS_MRG + (size_t)MP * D * 4;
constexpr size_t WS_MIX = WS_MERGED + (size_t)MP * D * 2;
constexpr size_t WS_S5A = WS_MIX + (size_t)MP * D * 4;
constexpr size_t WS_S5B = WS_S5A + (size_t)DEPTH * 4096 * 2 * 4;
constexpr size_t WS_BIAS = WS_S5B + (size_t)DEPTH * 4096 * 32 * 4;
constexpr size_t WS_VT = WS_BIAS + 16 * 128 * 4;
constexpr size_t WS_W1T = WS_VT + (size_t)256 * MP * 2;
constexpr size_t WS_W2T = WS_W1T + (size_t)DEPTH * 64 * 128 * 256 * 2;
constexpr size_t WS_KLAG = WS_W2T + (size_t)DEPTH * 64 * 16 * 16 * 128 * 2;
constexpr size_t WS_A16 = WS_KLAG + al256((size_t)DEPTH * 64 * 17 * 256 * 2);
constexpr int GLA_NCH = 65, GLA_ITEMS = NB * 4 * GLA_NCH;
constexpr size_t WS_GQE = WS_A16 + (size_t)DEPTH * 4096 * 2 * 4;
constexpr size_t WS_GKET = WS_GQE + (size_t)GLA_ITEMS * 8192;
constexpr size_t WS_GATT = WS_GKET + (size_t)GLA_ITEMS * 8192;
constexpr size_t WS_GV = WS_GATT + (size_t)GLA_ITEMS * 2048;
constexpr size_t WS_GCD = WS_GV + (size_t)GLA_ITEMS * 16384;
constexpr size_t WS_END = WS_GCD + (size_t)GLA_ITEMS * 512;

__device__ __forceinline__ unsigned cvt_pk_bf16(float lo, float hi) { unsigned r; asm volatile("v_cvt_pk_bf16_f32 %0, %1, %2" : "=v"(r) : "v"(lo), "v"(hi)); return r; }
typedef __bf16 bf16x2v __attribute__((ext_vector_type(2)));
typedef float f32x16 __attribute__((ext_vector_type(16)));
__device__ __forceinline__ unsigned pk_bf16(float a, float b) { const f32x2 v = {a, b}; const bf16x2v r = __builtin_convertvector(v, bf16x2v); return __builtin_bit_cast(unsigned, r); }
__device__ __forceinline__ bf16_t f2bf(float f) { return (bf16_t)(cvt_pk_bf16(f, 0.f) & 0xffffu); }
__device__ __forceinline__ float bf2f(bf16_t b) { return __uint_as_float(((unsigned)b) << 16); }
__device__ __forceinline__ float bflo(unsigned u) { return __uint_as_float(u << 16); }
__device__ __forceinline__ float bfhi(unsigned u) { return __uint_as_float(u & 0xffff0000u); }
__device__ __forceinline__ float wave_sum(float v) {
#pragma unroll
    for (int o = 32; o >= 1; o >>= 1) v += __shfl_xor(v, o);
    return v; }
__device__ __forceinline__ float wave_max(float v) {
#pragma unroll
    for (int o = 32; o >= 1; o >>= 1) v = fmaxf(v, __shfl_xor(v, o));
    return v; }
__device__ __forceinline__ float sigmoidf_(float x) { return 1.0f / (1.0f + __expf(-x)); }
__device__ __forceinline__ float gelu_tanh(float y) { const float a = 0.7978845608028654f * (y + 0.044715f * y * y * y); const float e = __expf(2.0f * a); const float th = 1.0f - 2.0f / (e + 1.0f); return 0.5f * y * (1.0f + th); }

#define XB_TMO      128
#define XB_XCNT(j)  (256  + 64 * (j))
#define XB_XSUB(j)  (1280 + 64 * (j))
#define XB_XGEN(j)  (2304 + 64 * (j))
#define XB_TOP      3328
#define XB_TOPGEN   3392
#define XCD_BAR_WORDS 3456
#define XB_SPIN_CAP (1u << 18)

__device__ __forceinline__ unsigned xb_ld(unsigned* p)              { return __hip_atomic_load(p, __ATOMIC_RELAXED, __HIP_MEMORY_SCOPE_AGENT); }
__device__ __forceinline__ unsigned xb_add(unsigned* p, unsigned v) { return __hip_atomic_fetch_add(p, v, __ATOMIC_RELAXED, __HIP_MEMORY_SCOPE_AGENT); }
__device__ __forceinline__ unsigned xb_xcc_id() { return (unsigned)__builtin_amdgcn_s_getreg((3 << 11) | 20) & 0xFu; }
#define XB_SPIN(cond, bar) do { unsigned _sp = 0; while (cond) { __builtin_amdgcn_s_sleep(1); \
    if ((++_sp & 255u) == 0u) { if (xb_ld(&(bar)[XB_TMO])) break; if (_sp > XB_SPIN_CAP) { atomicAdd(&(bar)[XB_TMO], 1u); break; } } } } while (0)

struct XcdBarrier {
    unsigned* bar; unsigned x;
    volatile LAS unsigned* st;
};

__device__ __forceinline__ XcdBarrier xcd_barrier_post(unsigned* bar, volatile LAS unsigned* st) {
    XcdBarrier b; b.bar = bar; b.x = xb_xcc_id(); b.st = st;
    if (threadIdx.x == 0) (void)xb_add(&bar[XB_XCNT(b.x)], 1u);
    return b;
}
__device__ __forceinline__ void xcd_barrier_complete(unsigned* bar, unsigned x, unsigned& nloc, unsigned& nx) {
    const unsigned G = gridDim.x * gridDim.y * gridDim.z;
    unsigned sum, cnt, mine, sp = 0u;
    for (;;) {
        sum = 0u; cnt = 0u; mine = 0u;
#pragma unroll
        for (unsigned j = 0; j < 16; ++j) { const unsigned c = xb_ld(&bar[XB_XCNT(j)]); sum += c; cnt += (c > 0u) ? 1u : 0u; mine = (j == x) ? c : mine; }
        if (sum == G) break;
        __builtin_amdgcn_s_sleep(1);
        if ((++sp & 255u) == 0u) { if (xb_ld(&bar[XB_TMO])) break; if (sp > XB_SPIN_CAP) { atomicAdd(&bar[XB_TMO], 1u); break; } }
    }
    nloc = mine > 0u ? mine : 1u; nx = cnt > 0u ? cnt : 1u;
}

__device__ __forceinline__ void xcd_barrier(const XcdBarrier& b) {
    asm volatile("s_waitcnt vmcnt(0)" ::: "memory");
    __syncthreads();
    if (threadIdx.x == 0) {
        unsigned* bar = b.bar;
        __builtin_amdgcn_s_waitcnt(0);
        unsigned nloc = b.st[0], nx = b.st[1];
        if (nloc == 0u) { xcd_barrier_complete(bar, b.x, nloc, nx); b.st[0] = nloc; b.st[1] = nx; }
        const unsigned old = xb_add(&bar[XB_XSUB(b.x)], 1u);
        const unsigned gen = old / nloc;
        if (old + 1u == (gen + 1u) * nloc) {
            __builtin_amdgcn_fence(__ATOMIC_RELEASE, "agent");
            asm volatile("s_waitcnt vmcnt(0)" ::: "memory");
            const unsigned og = xb_add(&bar[XB_TOP], 1u);
            const unsigned tg = og / nx;
            if (og + 1u == (tg + 1u) * nx) xb_add(&bar[XB_TOPGEN], 1u);
            else XB_SPIN(xb_ld(&bar[XB_TOPGEN]) == tg, bar);
            __builtin_amdgcn_fence(__ATOMIC_ACQUIRE, "agent");
            xb_add(&bar[XB_XGEN(b.x)], 1u);
            asm volatile("s_waitcnt vmcnt(0)" ::: "memory");
        } else {
            XB_SPIN(xb_ld(&bar[XB_XGEN(b.x)]) == gen, bar);
            __builtin_amdgcn_fence(__ATOMIC_ACQUIRE, "agent");
            asm volatile("s_waitcnt vmcnt(0)" ::: "memory");
        }
    }
    __syncthreads();
}

namespace pg8 {
#define PG8_LAS __attribute__((address_space(3)))
typedef unsigned short bf16_t;
typedef short bf16x8 __attribute__((ext_vector_type(8)));
typedef float f32x4 __attribute__((ext_vector_type(4)));
typedef unsigned u32x4 __attribute__((ext_vector_type(4)));
constexpr int BM = 256, BK = 64, HALF = 128, HTB = HALF * BK * 2  , STAGE_BYTES = 8 * HTB, NXCD = 8, WGM = 8;

__host__ __device__ __forceinline__ int lds_byte(int r, int c) { const int st = (r >> 4) * 2 + (c >> 5), rr = r & 15, cc = c & 31, ob = rr * 64 + cc * 2; return st * 1024 + (ob ^ (((ob >> 9) & 1) << 5)); }
__host__ __device__ __forceinline__ void stage_rc(int b, int& R, int& C) { const int st = b / 1024, sb = b % 1024, swz = sb ^ (((sb >> 9) & 1) << 5); R = (st >> 1) * 16 + swz / 64; C = (st & 1) * 32 + (swz % 64) / 2; }
__host__ __device__ __forceinline__ int perm32(int rho) { const int n = rho >> 4, i = rho & 15; return 8 * (i >> 2) + 4 * n + (i & 3); }

struct Unit { int pm, pn; };
struct Gemm { const bf16_t* A; const bf16_t* Bt; int M, N, K; };

struct StaticOrder {
    int nM, nN, nwg, G, c;
    __host__ __device__ void init(int M, int N, int G_, int c_) { nM = M / BM; nN = N / BM; nwg = nM * nN; G = G_; c = c_; }
    __host__ __device__ bool next(int i, Unit& u) const {
        const long L = (long)i * G + c; if (L >= nwg) return false;
        int wgid = (int)L; { const int q = nwg / NXCD, r = nwg % NXCD, xcd = wgid % NXCD, off = wgid / NXCD; wgid = (xcd < r ? xcd * (q + 1) : r * (q + 1) + (xcd - r) * q) + off; }
        const int nig = WGM * nN, gid = wgid / nig, fm = gid * WGM, gsz = (nM - fm) < WGM ? (nM - fm) : WGM;
        u.pm = fm + ((wgid % nig) % gsz); u.pn = (wgid % nig) / gsz; return true;
    }
    __device__ __forceinline__ void a_ready(const Unit&) const {}
    __device__ __forceinline__ void done(const Unit&) const {}
};

__device__ __forceinline__ unsigned cvt_pk_bf16(float lo, float hi) { unsigned r; asm volatile("v_cvt_pk_bf16_f32 %0, %1, %2" : "=v"(r) : "v"(lo), "v"(hi)); return r; }
__device__ __forceinline__ float sigm(float x) { return 1.0f / (1.0f + __expf(-x)); }

struct EpiF32 {
    static constexpr bool PERM = false, AFTER_DRAIN = false;
    float* C; int ldc;
    __device__ __forceinline__ void operator()(const f32x4 (&acc)[2][2][4][2], const Unit& u, int wr, int wc, int fr, int fq) const {
        const int row0 = u.pm * BM + wr * 64 + fr, col0 = u.pn * BM + wc * 32 + 4 * fq;
#pragma unroll
        for (int ai = 0; ai < 2; ++ai)
#pragma unroll
            for (int m = 0; m < 4; ++m) { float* rowp = C + (size_t)(row0 + ai * HALF + m * 16) * ldc + col0;
#pragma unroll
                for (int bj = 0; bj < 2; ++bj)
#pragma unroll
                    for (int n = 0; n < 2; ++n) *(f32x4*)(rowp + bj * HALF + n * 16) = acc[ai][bj][m][n]; }
    }
};
struct EpiIn {
    static constexpr bool PERM = true, AFTER_DRAIN = false;
    bf16_t* O; int ldc; bf16_t* VT; int ldvt;
    __device__ __forceinline__ void operator()(const f32x4 (&acc)[2][2][4][2], const Unit& u, int wr, int wc, int fr, int fq) const {
        const int row0 = u.pm * BM + wr * 64 + fr, col0 = u.pn * BM + wc * 32 + 8 * fq;
        const int pn = u.pn;
        const int act = (pn >= 22) ? 1 : ((pn >= 12 && pn < 16) ? 2 : ((pn == 4 || pn == 5 || (pn >= 16 && pn < 20)) ? 3 : 0));
        const float sc = (pn == 4 || pn == 5) ? 0.08838834764831845f : 0.125f;
#pragma unroll
        for (int ai = 0; ai < 2; ++ai)
#pragma unroll
            for (int m = 0; m < 4; ++m) { bf16_t* rowp = O + (size_t)(row0 + ai * HALF + m * 16) * ldc + col0;
#pragma unroll
                for (int bj = 0; bj < 2; ++bj) { f32x4 v0 = acc[ai][bj][m][0], v1 = acc[ai][bj][m][1];
                    if (act == 1) {
#pragma unroll
                        for (int j = 0; j < 4; ++j) { v0[j] = sigm(v0[j]); v1[j] = sigm(v1[j]); } }
                    else if (act == 2) {
#pragma unroll
                        for (int j = 0; j < 4; ++j) { v0[j] = v0[j] * sigm(v0[j]); v1[j] = v1[j] * sigm(v1[j]); } }
                    else if (act == 3) { v0 = v0 * sc; v1 = v1 * sc; }
                    u32x4 w; w.x = cvt_pk_bf16(v0[0], v0[1]); w.y = cvt_pk_bf16(v0[2], v0[3]); w.z = cvt_pk_bf16(v1[0], v1[1]); w.w = cvt_pk_bf16(v1[2], v1[3]);
                    *(u32x4*)(rowp + bj * HALF) = w;
                    if (pn == 21) { bf16_t* vt = VT + (size_t)(wc * 32 + 8 * fq + bj * HALF) * ldvt + (row0 + ai * HALF + m * 16);
                        vt[0] = (bf16_t)(w.x & 0xffffu); vt[(size_t)ldvt] = (bf16_t)(w.x >> 16); vt[(size_t)2 * ldvt] = (bf16_t)(w.y & 0xffffu); vt[(size_t)3 * ldvt] = (bf16_t)(w.y >> 16);
                        vt[(size_t)4 * ldvt] = (bf16_t)(w.z & 0xffffu); vt[(size_t)5 * ldvt] = (bf16_t)(w.z >> 16); vt[(size_t)6 * ldvt] = (bf16_t)(w.w & 0xffffu); vt[(size_t)7 * ldvt] = (bf16_t)(w.w >> 16); } } }
    }
};
struct EpiFF1 {
    static constexpr bool PERM = true, AFTER_DRAIN = false;
    bf16_t* O; int ldc;
    __device__ __forceinline__ void operator()(const f32x4 (&acc)[2][2][4][2], const Unit& u, int wr, int wc, int fr, int fq) const {
        const int row0 = u.pm * BM + wr * 64 + fr, col0 = u.pn * BM + wc * 32 + 8 * fq;
#pragma unroll
        for (int ai = 0; ai < 2; ++ai)
#pragma unroll
            for (int m = 0; m < 4; ++m) { bf16_t* rowp = O + (size_t)(row0 + ai * HALF + m * 16) * ldc + col0;
#pragma unroll
                for (int bj = 0; bj < 2; ++bj) { f32x4 v0 = acc[ai][bj][m][0], v1 = acc[ai][bj][m][1];
#pragma unroll
                    for (int j = 0; j < 4; ++j) { const float a = fmaxf(v0[j], 0.f), b = fmaxf(v1[j], 0.f); v0[j] = a * a; v1[j] = b * b; }
                    u32x4 w; w.x = cvt_pk_bf16(v0[0], v0[1]); w.y = cvt_pk_bf16(v0[2], v0[3]); w.z = cvt_pk_bf16(v1[0], v1[1]); w.w = cvt_pk_bf16(v1[2], v1[3]);
                    *(u32x4*)(rowp + bj * HALF) = w; } }
    }
};
struct EpiGlu {
    static constexpr bool PERM = true, AFTER_DRAIN = false;
    bf16_t* O; const bf16_t* Zs; const float* bias; int ldc;
    __device__ __forceinline__ void operator()(const f32x4 (&acc)[2][2][4][2], const Unit& u, int wr, int wc, int fr, int fq) const {
        const int row0 = u.pm * BM + wr * 64 + fr, col0 = u.pn * BM + wc * 32 + 8 * fq;
        f32x4 bv[2][2];
#pragma unroll
        for (int bj = 0; bj < 2; ++bj)
#pragma unroll
            for (int n = 0; n < 2; ++n) bv[bj][n] = *(const f32x4*)(bias + col0 + bj * HALF + 4 * n);
#pragma unroll
        for (int ai = 0; ai < 2; ++ai)
#pragma unroll
            for (int m = 0; m < 4; ++m) { const size_t ro = (size_t)(row0 + ai * HALF + m * 16) * ldc + col0;
#pragma unroll
                for (int bj = 0; bj < 2; ++bj) { f32x4 v0 = acc[ai][bj][m][0] + bv[bj][0], v1 = acc[ai][bj][m][1] + bv[bj][1];
                    const u32x4 zz = *(const u32x4*)(Zs + ro + bj * HALF);
                    const float z0 = __uint_as_float(zz.x << 16), z1 = __uint_as_float(zz.x & 0xffff0000u), z2 = __uint_as_float(zz.y << 16), z3 = __uint_as_float(zz.y & 0xffff0000u);
                    const float z4 = __uint_as_float(zz.z << 16), z5 = __uint_as_float(zz.z & 0xffff0000u), z6 = __uint_as_float(zz.w << 16), z7 = __uint_as_float(zz.w & 0xffff0000u);
                    u32x4 w; w.x = cvt_pk_bf16(z0 * sigm(v0[0]), z1 * sigm(v0[1])); w.y = cvt_pk_bf16(z2 * sigm(v0[2]), z3 * sigm(v0[3]));
                    w.z = cvt_pk_bf16(z4 * sigm(v1[0]), z5 * sigm(v1[1])); w.w = cvt_pk_bf16(z6 * sigm(v1[2]), z7 * sigm(v1[3]));
                    *(u32x4*)(O + ro + bj * HALF) = w; } }
    }
};
template <int KB> struct EpiMerge {
    static constexpr bool PERM = false, AFTER_DRAIN = false;
    float* mrg; bf16_t* out; const bf16_t* gate; int ldg;
    __device__ __forceinline__ void operator()(const f32x4 (&acc)[2][2][4][2], const Unit& u, int wr, int wc, int fr, int fq) const {
        const int row0 = u.pm * BM + wr * 64 + fr, col0 = u.pn * BM + wc * 32 + 4 * fq;
#pragma unroll
        for (int ai = 0; ai < 2; ++ai)
#pragma unroll
            for (int m = 0; m < 4; ++m) { const size_t r = (size_t)(row0 + ai * HALF + m * 16);
#pragma unroll
                for (int bj = 0; bj < 2; ++bj)
#pragma unroll
                    for (int n = 0; n < 2; ++n) { const int c = col0 + bj * HALF + n * 16;
                        const u32x2 gg = *(const u32x2*)(gate + r * ldg + c);
                        f32x4 gv; gv[0] = __uint_as_float(gg.x << 16); gv[1] = __uint_as_float(gg.x & 0xffff0000u); gv[2] = __uint_as_float(gg.y << 16); gv[3] = __uint_as_float(gg.y & 0xffff0000u);
                        f32x4 v = gv * acc[ai][bj][m][n];
                        if (KB >= 1) v = v + *(const f32x4*)(mrg + r * 2048 + c);
                        if (KB <= 1) *(f32x4*)(mrg + r * 2048 + c) = v;
                        else { u32x2 w; w.x = cvt_pk_bf16(v[0], v[1]); w.y = cvt_pk_bf16(v[2], v[3]); *(u32x2*)(out + r * 2048 + c) = w; } }
                asm volatile("" ::: "memory"); }
    }
};

template <class Epi, class Sched, bool STAMP = false>
__device__ __forceinline__ void gemm_phase(PG8_LAS unsigned char* lds, const Gemm g, const Sched& S, const Epi& E, unsigned long long* stamps) {
    int tid_ = threadIdx.x; asm volatile("" : "+v"(tid_)); const int tid = tid_, wid = __builtin_amdgcn_readfirstlane(tid >> 6), lane = tid & 63, wr = wid >> 2, wc = wid & 3, fr = lane & 15, fq = lane >> 4;
    const int K = g.K, nt = K / BK;
    int ts_lo = 0, ts_hi = 0, nts = 0; const unsigned long long rt_entry = STAMP ? (unsigned long long)wall_clock64() : 0ull;
#define PG8_STAMP() do { if (STAMP && wid == 0 && nts < 64) { const unsigned long long _c = (unsigned long long)clock64(); \
        ts_lo = (lane == nts) ? (int)(unsigned)_c : ts_lo; ts_hi = (lane == nts) ? (int)(unsigned)(_c >> 32) : ts_hi; ++nts; } } while (0)
    PG8_STAMP();
    unsigned voffA[2], voffB[2];
#pragma unroll
    for (int i = 0; i < 2; ++i) { int R, C; stage_rc(tid * 16 + i * 8192, R, C); const int Rb = Epi::PERM ? ((R & ~31) + perm32(R & 31)) : R;
        voffA[i] = (unsigned)(R * K + C) * 2u; voffB[i] = (unsigned)(Rb * K + C) * 2u; }
    const size_t kstep = (size_t)(BK * 2);
    const size_t hstep = (size_t)HALF * K * 2;
    const size_t tstep = 2 * hstep;
    const unsigned ldsw = (unsigned)wid * 1024u;
    const int aoff = lds_byte(wr * 64 + fr, fq * 8), boff = lds_byte(wc * 32 + fr, fq * 8);
#define PG8_SA(b, h) (((b) * 2 + (h)) * HTB)
#define PG8_SB(b, h) ((4 + (b) * 2 + (h)) * HTB)
#define PG8_STAGE(bufoff, gbase, voff) do { _Pragma("unroll") for (int _i = 0; _i < 2; ++_i) \
        __builtin_amdgcn_global_load_lds((const unsigned*)((const char*)(gbase) + (voff)[_i]), (PG8_LAS unsigned*)(lds + (bufoff) + ldsw + _i * 8192), 16, 0, 0); } while (0)
#define PG8_LDA(dst, b, h) do { _Pragma("unroll") for (int m = 0; m < 4; ++m) _Pragma("unroll") for (int k = 0; k < 2; ++k) dst[m][k] = *(const PG8_LAS bf16x8*)(lds + PG8_SA(b, h) + aoff + m * 2048 + k * 1024); } while (0)
#define PG8_LDB(dst, b, h) do { _Pragma("unroll") for (int n = 0; n < 2; ++n) _Pragma("unroll") for (int k = 0; k < 2; ++k) dst[n][k] = *(const PG8_LAS bf16x8*)(lds + PG8_SB(b, h) + boff + n * 2048 + k * 1024); } while (0)
#define PG8_MMA(ai, bj, At, Bt) do { __builtin_amdgcn_s_setprio(1); _Pragma("unroll") for (int m = 0; m < 4; ++m) _Pragma("unroll") for (int n = 0; n < 2; ++n) _Pragma("unroll") for (int k = 0; k < 2; ++k) \
        acc[ai][bj][m][n] = __builtin_amdgcn_mfma_f32_16x16x32_bf16(Bt[n][k], At[m][k], acc[ai][bj][m][n], 0, 0, 0); __builtin_amdgcn_s_setprio(0); } while (0)
#define PG8_WAIT_V(n) asm volatile("s_waitcnt vmcnt(" #n ")" ::: "memory")
#define PG8_WAIT_L(n) asm volatile("s_waitcnt lgkmcnt(" #n ")" ::: "memory")
#define PG8_BAR __builtin_amdgcn_s_barrier()
#define PG8_SCHED __builtin_amdgcn_sched_barrier(0)
    Unit cur, nxt; int ui = 0;
    if (!S.next(0, cur)) return;
    f32x4 acc[2][2][4][2];
#pragma unroll
    for (int a = 0; a < 2; ++a)
#pragma unroll
        for (int b = 0; b < 2; ++b)
#pragma unroll
            for (int m = 0; m < 4; ++m)
#pragma unroll
                for (int n = 0; n < 2; ++n) acc[a][b][m][n] = (f32x4){0.f, 0.f, 0.f, 0.f};
    bf16x8 At[4][2], B0[2][2], B1[2][2];
    const char* cA = (const char*)g.A + (size_t)cur.pm * tstep; const char* cB = (const char*)g.Bt + (size_t)cur.pn * tstep;
    S.a_ready(cur);
    PG8_STAGE(PG8_SB(0, 0), cB, voffB); PG8_STAGE(PG8_SA(0, 0), cA, voffA); PG8_STAGE(PG8_SB(0, 1), cB + hstep, voffB); PG8_STAGE(PG8_SA(0, 1), cA + hstep, voffA);
    if (wr == 1) PG8_BAR;
    PG8_WAIT_V(4); PG8_BAR;
    PG8_STAGE(PG8_SB(1, 0), cB + kstep, voffB); PG8_STAGE(PG8_SA(1, 0), cA + kstep, voffA); PG8_STAGE(PG8_SB(1, 1), cB + hstep + kstep, voffB);
    PG8_WAIT_V(6); PG8_BAR;
    PG8_STAMP();
    for (;;) {
        const bool has_next = S.next(ui + 1, nxt);
        const char* nA = has_next ? (const char*)g.A + (size_t)nxt.pm * tstep : cA; const char* nB = has_next ? (const char*)g.Bt + (size_t)nxt.pn * tstep : cB;
        for (int t = 0; t < nt; t += 2) {
            const bool last = (t == nt - 2);
            const char* a1 = cA + (size_t)(t + 1) * kstep;
            const char* a2 = last ? nA : cA + (size_t)(t + 2) * kstep; const char* b2 = last ? nB : cB + (size_t)(t + 2) * kstep;
            const char* a3 = a2 + kstep; const char* b3 = b2 + kstep;
            if (last && has_next) S.a_ready(nxt);
            PG8_LDB(B0, 0, 0); PG8_SCHED; PG8_LDA(At, 0, 0); PG8_STAGE(PG8_SA(1, 1), a1 + hstep, voffA);
            PG8_WAIT_L(8); PG8_BAR; PG8_WAIT_L(0); PG8_MMA(0, 0, At, B0); PG8_BAR; PG8_SCHED;
            PG8_LDB(B1, 0, 1); PG8_STAGE(PG8_SB(0, 0), b2, voffB);
            PG8_BAR; PG8_WAIT_L(0); PG8_MMA(0, 1, At, B1); PG8_BAR;
            PG8_LDA(At, 0, 1); PG8_STAGE(PG8_SA(0, 0), a2, voffA);
            PG8_BAR; PG8_WAIT_L(0); PG8_MMA(1, 0, At, B0); PG8_BAR; PG8_SCHED;
            PG8_STAGE(PG8_SB(0, 1), b2 + hstep, voffB);
            PG8_WAIT_V(6); PG8_BAR; PG8_MMA(1, 1, At, B1); PG8_BAR;
            PG8_LDB(B0, 1, 0); PG8_SCHED; PG8_LDA(At, 1, 0); PG8_STAGE(PG8_SA(0, 1), a2 + hstep, voffA);
            PG8_WAIT_L(8); PG8_BAR; PG8_WAIT_L(0); PG8_MMA(0, 0, At, B0); PG8_BAR; PG8_SCHED;
            PG8_LDB(B1, 1, 1); PG8_STAGE(PG8_SB(1, 0), b3, voffB);
            PG8_BAR; PG8_WAIT_L(0); PG8_MMA(0, 1, At, B1); PG8_BAR;
            PG8_LDA(At, 1, 1); PG8_STAGE(PG8_SA(1, 0), a3, voffA);
            PG8_BAR; PG8_WAIT_L(0); PG8_MMA(1, 0, At, B0); PG8_BAR; PG8_SCHED;
            PG8_STAGE(PG8_SB(1, 1), b3 + hstep, voffB);
            PG8_WAIT_V(6); PG8_BAR; PG8_MMA(1, 1, At, B1); PG8_BAR;
        }
        PG8_STAMP();
        if constexpr (!Epi::AFTER_DRAIN) { E(acc, cur, wr, wc, fr, fq); S.done(cur); }
        PG8_STAMP();
        if (!has_next) break;
#pragma unroll
        for (int a = 0; a < 2; ++a)
#pragma unroll
            for (int b = 0; b < 2; ++b)
#pragma unroll
                for (int m = 0; m < 4; ++m)
#pragma unroll
                    for (int n = 0; n < 2; ++n) acc[a][b][m][n] = (f32x4){0.f, 0.f, 0.f, 0.f};
        cur = nxt; cA = nA; cB = nB; ++ui;
    }
    PG8_WAIT_V(0);
    if (wr == 0) PG8_BAR;
    PG8_BAR;
    if constexpr (Epi::AFTER_DRAIN) { E.fused(acc, cur, wr, wc, fr, fq, lds, wid, lane); S.done(cur); }
    PG8_STAMP();
    if (STAMP && wid == 0) { stamps[lane] = lane < nts ? (((unsigned long long)(unsigned)ts_hi << 32) | (unsigned)ts_lo) : 0ull;
        if (lane == 62) stamps[62] = rt_entry; if (lane == 63) stamps[63] = (unsigned long long)wall_clock64(); }
#undef PG8_STAMP
#undef PG8_SA
#undef PG8_SB
#undef PG8_STAGE
#undef PG8_LDA
#undef PG8_LDB
#undef PG8_MMA
#undef PG8_WAIT_V
#undef PG8_WAIT_L
#undef PG8_BAR
#undef PG8_SCHED
}
}

constexpr int NTHR = 512, NWAVE = 8;
constexpr int LDS_STAGE = 131072, LDS_MISC_OFF = LDS_STAGE, LDS_BYTES = LDS_STAGE + 4096;

struct Args { const float* in[N_IN]; float* out; unsigned char* ws; int ph_lo, ph_hi; };

struct Frame {
    const float* const* in; float* out; unsigned char* ws; LAS unsigned char* lds;
    int tid, lane, wave, G, bid;
    __device__ __forceinline__ void fresh() { int t = threadIdx.x; asm volatile("" : "+v"(t)); tid = t; lane = t & 63; wave = __builtin_amdgcn_readfirstlane(t >> 6); int b = blockIdx.x; asm volatile("" : "+s"(b)); bid = b; }
    bf16_t *Wt_in, *Wt_glu, *Wt_up, *Wt_out, *Wt_ff1, *Wt_ff2;
    float* X; bf16_t* H; float* AIN; bf16_t* Z; bf16_t* ZS5; bf16_t* Y; float* GLAO; float* DEC; float* MRG; bf16_t* MERGED; float* MIX; bf16_t* FFH;
    float* S5A; float* S5B; float* BIAS; bf16_t* VT; bf16_t* W1T; bf16_t* W2T; bf16_t* KLAG; float* A16; bf16_t* GQE; bf16_t* GKET; bf16_t* GATT; bf16_t* GV; float* GCD;
};

__device__ __forceinline__ void transpose_convert(const Frame& F, const float* __restrict__ src, bf16_t* __restrict__ dst, int K, int ld, int N, bool is_in) {
    const int ntn = N / 64, ntiles = ntn * (K / 64);
    for (int tile = F.bid * NWAVE + F.wave; tile < ntiles; tile += F.G * NWAVE) {
        const int kt = tile / ntn, nt = tile - kt * ntn, n0 = nt * 64, k0 = kt * 64;
        int sc = n0 + F.lane; if (is_in && sc >= 3072) sc += 16;
        const float* sp = src + (size_t)k0 * ld + sc;
        float v[64];
#pragma unroll
        for (int i = 0; i < 64; ++i) v[i] = sp[(size_t)i * ld];
        u32x4* dp = (u32x4*)(dst + (size_t)(n0 + F.lane) * K + k0);
#pragma unroll
        for (int j = 0; j < 8; ++j) { u32x4 w; w.x = cvt_pk_bf16(v[8 * j], v[8 * j + 1]); w.y = cvt_pk_bf16(v[8 * j + 2], v[8 * j + 3]); w.z = cvt_pk_bf16(v[8 * j + 4], v[8 * j + 5]); w.w = cvt_pk_bf16(v[8 * j + 6], v[8 * j + 7]); dp[j] = w; }
    }
}
__device__ __forceinline__ void prologue_phase(const Frame& F) {
    for (int l = 0; l < DEPTH; ++l) {
        transpose_convert(F, F.in[I_WIN] + (size_t)l * D * INW, F.Wt_in + (size_t)l * ZW * D, D, INW, ZW, true);
        transpose_convert(F, F.in[I_WGLU] + (size_t)l * 1024 * 1024, F.Wt_glu + (size_t)l * 1024 * 1024, 1024, 1024, 1024, false);
        transpose_convert(F, F.in[I_WUS5] + (size_t)l * 1024 * D, F.Wt_up + ((size_t)l * 3 + 0) * D * 1024, 1024, D, D, false);
        transpose_convert(F, F.in[I_WUGLA] + (size_t)l * 1024 * D, F.Wt_up + ((size_t)l * 3 + 1) * D * 1024, 1024, D, D, false);
        transpose_convert(F, F.in[I_WUSWA] + (size_t)l * 1024 * D, F.Wt_up + ((size_t)l * 3 + 2) * D * 1024, 1024, D, D, false);
        transpose_convert(F, F.in[I_WOUT] + (size_t)l * D * D, F.Wt_out + (size_t)l * D * D, D, D, D, false);
        transpose_convert(F, F.in[I_WFF1] + (size_t)l * D * DFF, F.Wt_ff1 + (size_t)l * DFF * D, D, DFF, DFF, false);
        transpose_convert(F, F.in[I_WFF2] + (size_t)l * DFF * D, F.Wt_ff2 + (size_t)l * D * DFF, DFF, D, D, false);
    }
    for (int idx = F.bid * NTHR + F.tid; idx < DEPTH * 4096; idx += F.G * NTHR) {
        const int l = idx >> 12, g = (idx >> 6) & 63;
        const double dt = exp((double)F.in[I_LSTEP][l * 64 + g]);
        const double lr = (double)F.in[I_LRE][idx], li = (double)F.in[I_LIM][idx];
        const double mag = exp(lr * dt), ar = mag * cos(li * dt), ai = mag * sin(li * dt);
        const double den = lr * lr + li * li;
        const double fr = ((ar - 1.0) * lr + ai * li) / den, fi = (ai * lr - (ar - 1.0) * li) / den;
        F.S5A[idx * 2 + 0] = (float)ar; F.S5A[idx * 2 + 1] = (float)ai;
        const float* br = F.in[I_BRE] + (size_t)idx * 16; const float* bi = F.in[I_BIM] + (size_t)idx * 16;
        float* o = F.S5B + (size_t)idx * 32;
#pragma unroll
        for (int h = 0; h < 16; ++h) { const double b_r = br[h], b_i = bi[h]; o[h] = (float)(fr * b_r - fi * b_i); o[16 + h] = (float)(fr * b_i + fi * b_r); }
    }
    for (int idx = F.bid * NTHR + F.tid; idx < DEPTH * 4096; idx += F.G * NTHR) {
        const int l = idx >> 12, g = (idx >> 6) & 63, p = idx & 63;
        const double dt = exp((double)F.in[I_LSTEP][l * 64 + g]);
        const double lr = (double)F.in[I_LRE][idx], li = (double)F.in[I_LIM][idx];
        const double mag = exp(lr * dt), ar = mag * cos(li * dt), ai = mag * sin(li * dt);
        const double den = lr * lr + li * li;
        const double fr = ((ar - 1.0) * lr + ai * li) / den, fi = (ai * lr - (ar - 1.0) * li) / den;
        const float* br = F.in[I_BRE] + (size_t)idx * 16; const float* bi = F.in[I_BIM] + (size_t)idx * 16;
        bf16_t* w1 = F.W1T + (size_t)(l * 64 + g) * 128 * 256;
        double pr = 1.0, pi = 0.0;
        for (int k = 0; k < 16; ++k) { const int s = 15 - k;
            unsigned wr_[8], wi_[8];
#pragma unroll
            for (int h2 = 0; h2 < 8; ++h2) {
                const double b0r = fr * br[2 * h2] - fi * bi[2 * h2], b0i = fr * bi[2 * h2] + fi * br[2 * h2], b1r = fr * br[2 * h2 + 1] - fi * bi[2 * h2 + 1], b1i = fr * bi[2 * h2 + 1] + fi * br[2 * h2 + 1];
                wr_[h2] = pk_bf16((float)(pr * b0r - pi * b0i), (float)(pr * b1r - pi * b1i)); wi_[h2] = pk_bf16((float)(pr * b0i + pi * b0r), (float)(pr * b1i + pi * b1r)); }
            u32x4* d0 = (u32x4*)(w1 + ((size_t)p * 16 + s) * 16); u32x4* d1 = (u32x4*)(w1 + ((size_t)(64 + p) * 16 + s) * 16);
            d0[0] = (u32x4){wr_[0], wr_[1], wr_[2], wr_[3]}; d0[1] = (u32x4){wr_[4], wr_[5], wr_[6], wr_[7]};
            d1[0] = (u32x4){wi_[0], wi_[1], wi_[2], wi_[3]}; d1[1] = (u32x4){wi_[4], wi_[5], wi_[6], wi_[7]};
            const double nr = pr * ar - pi * ai, ni = pr * ai + pi * ar; pr = nr; pi = ni; }
        F.A16[idx * 2] = (float)pr; F.A16[idx * 2 + 1] = (float)pi;
        bf16_t* w2 = F.W2T + (size_t)(l * 64 + g) * 16 * 16 * 128;
        double qr = ar, qi = ai;
        for (int t = 0; t < 16; ++t) {
            for (int h = 0; h < 16; ++h) { const double cr = F.in[I_CRE][((size_t)(l * 64 + g) * 16 + h) * 64 + p], ci = F.in[I_CIM][((size_t)(l * 64 + g) * 16 + h) * 64 + p];
                w2[((size_t)t * 16 + h) * 128 + p] = f2bf((float)(cr * qr - ci * qi)); w2[((size_t)t * 16 + h) * 128 + 64 + p] = f2bf((float)(-(cr * qi + ci * qr))); }
            const double nr = qr * ar - qi * ai, ni = qr * ai + qi * ar; qr = nr; qi = ni; }
    }
    for (int idx = F.bid * NTHR + F.tid; idx < DEPTH * 64 * 256; idx += F.G * NTHR) {
        const int l = idx >> 14, g = (idx >> 8) & 63, h = (idx >> 4) & 15, hp = idx & 15;
        const double dt = exp((double)F.in[I_LSTEP][l * 64 + g]);
        double acc[16];
#pragma unroll
        for (int t = 0; t < 16; ++t) acc[t] = 0.0;
        for (int p = 0; p < 64; ++p) { const int gi = (l * 64 + g) * 64 + p;
            const double lr = (double)F.in[I_LRE][gi], li = (double)F.in[I_LIM][gi];
            const double mag = exp(lr * dt), ar = mag * cos(li * dt), ai = mag * sin(li * dt);
            const double den = lr * lr + li * li;
            const double fr = ((ar - 1.0) * lr + ai * li) / den, fi = (ai * lr - (ar - 1.0) * li) / den;
            const double b_r = F.in[I_BRE][(size_t)gi * 16 + hp], b_i = F.in[I_BIM][(size_t)gi * 16 + hp];
            const double bbr = fr * b_r - fi * b_i, bbi = fr * b_i + fi * b_r;
            const double cr = F.in[I_CRE][((size_t)(l * 64 + g) * 16 + h) * 64 + p], ci = F.in[I_CIM][((size_t)(l * 64 + g) * 16 + h) * 64 + p];
            double vr = cr * bbr - ci * bbi, vi = cr * bbi + ci * bbr;
#pragma unroll
            for (int t = 0; t < 16; ++t) { acc[t] += vr; const double nr = vr * ar - vi * ai, ni = vr * ai + vi * ar; vr = nr; vi = ni; } }
        bf16_t* kl = F.KLAG + (size_t)(l * 64 + g) * 17 * 256;
        kl[h * 16 + hp] = 0;
#pragma unroll
        for (int t = 0; t < 16; ++t) kl[(t + 1) * 256 + h * 16 + hp] = f2bf((float)acc[t]);
    }
    for (int idx = F.bid * NTHR + F.tid; idx < 16 * 128; idx += F.G * NTHR) {
        const int hq = idx >> 7, d = idx & 127;
        int bucket = d;
        if (d >= 16) { bucket = 16 + (int)(log((double)d / 16.0) / log(8.0) * 16.0); if (bucket > 31) bucket = 31; }
        F.BIAS[idx] = F.in[I_RELB][bucket * 16 + hq];
    }
}

template <int MODE>
__device__ __forceinline__ void norm_phase(const Frame& F, int l) {
    constexpr bool AIN = (MODE == 0 || MODE == 2);
    const float* gA = (MODE == 1) ? F.in[I_NQM] + l * D : (MODE == 2) ? F.in[I_NQF] + (l - 1) * D : F.in[I_NQF] + 3 * D;
    const float* gB = (MODE == 0) ? F.in[I_NPM] : (MODE == 1) ? F.in[I_NPF] + l * D : F.in[I_NPM] + l * D;
    LAS f32x4* WaL = (LAS f32x4*)F.lds;
    if (AIN) {
        const float* wl = F.in[I_WIN] + (size_t)l * D * INW + 3072;
        for (int idx = F.tid; idx < 2048 * 4; idx += NTHR) { const int k = idx >> 2, nq = idx & 3;
            const f32x4 w = *(const f32x4*)(wl + (size_t)k * INW + nq * 4);
            const int kk = k >> 8, ln = (k & 255) >> 2, j = k & 3;
            WaL[((kk * 4 + j) * 4 + nq) * 64 + ln] = w; }
        __syncthreads();
    }
    for (int row = F.bid * NWAVE + F.wave; row < MP; row += F.G * NWAVE) {
        if (row >= MREAL) {
            if (MODE == 0) { const f32x4 z4 = {0.f, 0.f, 0.f, 0.f}; const u32x2 z2 = {0u, 0u};
#pragma unroll
                for (int kk = 0; kk < 8; ++kk) { ((f32x4*)(F.X + (size_t)row * D))[kk * 64 + F.lane] = z4; ((u32x2*)(F.H + (size_t)row * D))[kk * 64 + F.lane] = z2; }
                if (F.lane < 16) F.AIN[row * 16 + F.lane] = 0.f; }
            continue;
        }
        f32x4 xv[8];
        const f32x4* xs;
        if (MODE == 0) {
            if (row < ROWS_P) { const int b = row / TP, t = row - b * TP; xs = (t < NMETA) ? (const f32x4*)(F.in[I_META] + (size_t)t * D) : (const f32x4*)(F.in[I_XP] + ((size_t)b * SEQ + (t - NMETA)) * D); }
            else xs = (const f32x4*)(F.in[I_XS] + (size_t)(row - ROWS_P) * D);
        } else xs = (const f32x4*)(F.X + (size_t)row * D);
#pragma unroll
        for (int kk = 0; kk < 8; ++kk) xv[kk] = xs[kk * 64 + F.lane];
        if (MODE != 0) {
            const f32x4* rs_ = (const f32x4*)(F.MIX + (size_t)row * D);
            f32x4 rv[8]; float ss = 0.f;
#pragma unroll
            for (int kk = 0; kk < 8; ++kk) { rv[kk] = rs_[kk * 64 + F.lane]; ss += rv[kk][0] * rv[kk][0] + rv[kk][1] * rv[kk][1] + rv[kk][2] * rv[kk][2] + rv[kk][3] * rv[kk][3]; }
            ss = wave_sum(ss);
            const float rs = 1.0f / sqrtf(ss * (1.0f / D) + EPS);
#pragma unroll
            for (int kk = 0; kk < 8; ++kk) { const f32x4 ga = ((const f32x4*)gA)[kk * 64 + F.lane]; xv[kk] = xv[kk] + rv[kk] * rs * ga; }
        }
        if (MODE == 3) {
            f32x4* od = nullptr;
            if (row < ROWS_P) { const int b = row / TP, t = row - b * TP; if (t >= NMETA) od = (f32x4*)(F.out + O_YP + ((size_t)b * SEQ + (t - NMETA)) * D); }
            else od = (f32x4*)(F.out + O_YS + (size_t)(row - ROWS_P) * D);
            if (od) {
#pragma unroll
                for (int kk = 0; kk < 8; ++kk) od[kk * 64 + F.lane] = xv[kk]; }
            continue;
        }
#pragma unroll
        for (int kk = 0; kk < 8; ++kk) ((f32x4*)(F.X + (size_t)row * D))[kk * 64 + F.lane] = xv[kk];
        float ss2 = 0.f;
#pragma unroll
        for (int kk = 0; kk < 8; ++kk) ss2 += xv[kk][0] * xv[kk][0] + xv[kk][1] * xv[kk][1] + xv[kk][2] * xv[kk][2] + xv[kk][3] * xv[kk][3];
        ss2 = wave_sum(ss2);
        const float rs2 = 1.0f / sqrtf(ss2 * (1.0f / D) + EPS);
#pragma unroll
        for (int kk = 0; kk < 8; ++kk) { const f32x4 gb = ((const f32x4*)gB)[kk * 64 + F.lane]; xv[kk] = xv[kk] * rs2 * gb;
            u32x2 w; w.x = cvt_pk_bf16(xv[kk][0], xv[kk][1]); w.y = cvt_pk_bf16(xv[kk][2], xv[kk][3]); ((u32x2*)(F.H + (size_t)row * D))[kk * 64 + F.lane] = w; }
        if (AIN) {
            float acc[16];
#pragma unroll
            for (int n = 0; n < 16; ++n) acc[n] = 0.f;
#pragma unroll
            for (int kk = 0; kk < 8; ++kk)
#pragma unroll
                for (int j = 0; j < 4; ++j) { const float hv = xv[kk][j];
#pragma unroll
                    for (int nq = 0; nq < 4; ++nq) { const f32x4 w = WaL[((kk * 4 + j) * 4 + nq) * 64 + F.lane];
                        acc[nq * 4 + 0] += hv * w[0]; acc[nq * 4 + 1] += hv * w[1]; acc[nq * 4 + 2] += hv * w[2]; acc[nq * 4 + 3] += hv * w[3]; } }
#pragma unroll
            for (int n = 0; n < 16; ++n) acc[n] = wave_sum(acc[n]);
            float mine = 0.f;
#pragma unroll
            for (int n = 0; n < 16; ++n) mine = (F.lane == n) ? acc[n] : mine;
            if (F.lane < 16) F.AIN[row * 16 + F.lane] = mine;
        }
    }
    if (AIN) __syncthreads();
}

__device__ __forceinline__ void gla_pre_phase(const Frame& F, int l) {
    const int t = F.tid & 127, sub = F.tid >> 7;
    const float* wg = F.in[I_WG2] + (size_t)l * 16 * 512 + 4 * t;
    f32x4 w[16];
#pragma unroll
    for (int r = 0; r < 16; ++r) w[r] = *(const f32x4*)(wg + r * 512);
    const f32x4 bg = *(const f32x4*)(F.in[I_BG2] + l * 512 + 4 * t);
    for (int row = ROWS_P + F.bid * 4 + sub; row < MREAL; row += F.G * 4) {
        f32x4 a[4];
#pragma unroll
        for (int q = 0; q < 4; ++q) a[q] = *(const f32x4*)(F.AIN + row * 16 + q * 4);
        f32x4 pre = bg;
#pragma unroll
        for (int r = 0; r < 16; ++r) pre = pre + w[r] * a[r >> 2][r & 3];
        f32x4 o;
#pragma unroll
        for (int c = 0; c < 4; ++c) { const float x = pre[c]; const float ls = fminf(x, 0.f) - log1pf(expf(-fabsf(x))); o[c] = expf(ls * 0.0625f); }
        *(f32x4*)(F.DEC + (size_t)row * 512 + 4 * t) = o;
    }
}

template <bool PROMPT>
__device__ __forceinline__ void s5_naive_phase(const Frame& F, int l) {
    LAS f32x2* sx = (LAS f32x2*)F.lds + F.wave * 64;
    const int p = F.lane, h = F.lane & 15, q = F.lane >> 4;
    for (int it = (PROMPT ? 0 : 256) + F.bid * NWAVE + F.wave; it < 36 * 64; it += F.G * NWAVE) {
        int g, T, row0, nseq; bool prompt;
        if (it < 256) { nseq = it >> 6; g = it & 63; T = TP; row0 = nseq * TP; prompt = true; }
        else { const int j = it - 256; nseq = j >> 6; g = j & 63; T = 1; row0 = ROWS_P + nseq; prompt = false; }
        const int gi = (l * 64 + g) * 64 + p;
        const float ar = F.S5A[gi * 2], ai = F.S5A[gi * 2 + 1];
        float bbr[16], bbi[16];
#pragma unroll
        for (int c = 0; c < 4; ++c) { const f32x4 a = *(const f32x4*)(F.S5B + (size_t)gi * 32 + c * 4), b = *(const f32x4*)(F.S5B + (size_t)gi * 32 + 16 + c * 4);
            bbr[c * 4] = a[0]; bbr[c * 4 + 1] = a[1]; bbr[c * 4 + 2] = a[2]; bbr[c * 4 + 3] = a[3]; bbi[c * 4] = b[0]; bbi[c * 4 + 1] = b[1]; bbi[c * 4 + 2] = b[2]; bbi[c * 4 + 3] = b[3]; }
        float cr[16], ci[16];
        { const float* crp = F.in[I_CRE] + ((size_t)(l * 64 + g) * 16 + h) * 64 + q * 16; const float* cip = F.in[I_CIM] + ((size_t)(l * 64 + g) * 16 + h) * 64 + q * 16;
#pragma unroll
            for (int c = 0; c < 4; ++c) { const f32x4 a = *(const f32x4*)(crp + c * 4), b = *(const f32x4*)(cip + c * 4);
                cr[c * 4] = a[0]; cr[c * 4 + 1] = a[1]; cr[c * 4 + 2] = a[2]; cr[c * 4 + 3] = a[3]; ci[c * 4] = b[0]; ci[c * 4 + 1] = b[1]; ci[c * 4 + 2] = b[2]; ci[c * 4 + 3] = b[3]; } }
        const float dsk = F.in[I_SD][l * 1024 + g * 16 + h];
        float xr = 0.f, xi = 0.f;
        if (!prompt) { xr = F.in[I_S5R][((size_t)(l * NDEC + nseq) * 64 + g) * 64 + p]; xi = F.in[I_S5I][((size_t)(l * NDEC + nseq) * 64 + g) * 64 + p]; }
        const bf16_t* up = F.Z + (size_t)row0 * ZW + ZU + g * 16;
        u32x4 u0 = *(const u32x4*)up, u1 = *(const u32x4*)(up + 8);
        for (int t = 0; t < T; ++t) {
            const u32x4 c0 = u0, c1 = u1;
            const float uh = bf2f(up[(size_t)t * ZW + h]);
            if (t + 1 < T) { u0 = *(const u32x4*)(up + (size_t)(t + 1) * ZW); u1 = *(const u32x4*)(up + (size_t)(t + 1) * ZW + 8); }
            float uu[16];
            uu[0] = bflo(c0.x); uu[1] = bfhi(c0.x); uu[2] = bflo(c0.y); uu[3] = bfhi(c0.y); uu[4] = bflo(c0.z); uu[5] = bfhi(c0.z); uu[6] = bflo(c0.w); uu[7] = bfhi(c0.w);
            uu[8] = bflo(c1.x); uu[9] = bfhi(c1.x); uu[10] = bflo(c1.y); uu[11] = bfhi(c1.y); uu[12] = bflo(c1.z); uu[13] = bfhi(c1.z); uu[14] = bflo(c1.w); uu[15] = bfhi(c1.w);
            float er = 0.f, ei = 0.f;
#pragma unroll
            for (int c = 0; c < 16; ++c) { er += bbr[c] * uu[c]; ei += bbi[c] * uu[c]; }
            const float nxr = ar * xr - ai * xi + er, nxi = ar * xi + ai * xr + ei;
            xr = nxr; xi = nxi;
            sx[p] = (f32x2){xr, xi};
            asm volatile("s_waitcnt lgkmcnt(0)" ::: "memory");
            float ys = 0.f;
#pragma unroll
            for (int c = 0; c < 16; ++c) { const f32x2 xv = sx[q * 16 + c]; ys += cr[c] * xv[0] - ci[c] * xv[1]; }
            asm volatile("s_waitcnt lgkmcnt(0)" ::: "memory");
            ys += __shfl_xor(ys, 16); ys += __shfl_xor(ys, 32);
            if (F.lane < 16) { const float y = ys + dsk * uh; F.ZS5[(size_t)(row0 + t) * 1024 + g * 16 + h] = f2bf(gelu_tanh(y)); }
        }
        if (prompt) { F.out[O_PS5R + ((size_t)(l * NB + nseq) * 64 + g) * 64 + p] = xr; F.out[O_PS5I + ((size_t)(l * NB + nseq) * 64 + g) * 64 + p] = xi; }
        else { F.out[O_SS5R + ((size_t)(l * NDEC + nseq) * 64 + g) * 64 + p] = xr; F.out[O_SS5I + ((size_t)(l * NDEC + nseq) * 64 + g) * 64 + p] = xi; }
    }
}

__device__ __forceinline__ void gla_naive_phase(const Frame& F, int l, int bid0) {
    const int v = F.lane & 15, dq = F.lane >> 4;
    for (int it = 256 + (F.bid - bid0) * NWAVE + F.wave; it < 36 * 64; it += (F.G - bid0) * NWAVE) {
        int nseq, hd, dv, T, row0; bool prompt;
        if (it < 256) { nseq = it >> 6; hd = (it >> 4) & 3; dv = it & 15; T = TP; row0 = nseq * TP; prompt = true; }
        else { const int j = it - 256; nseq = j >> 6; hd = (j >> 4) & 3; dv = j & 15; T = 1; row0 = ROWS_P + nseq; prompt = false; }
        float S[32];
        float* sout = prompt ? F.out + O_PGLA + (((size_t)(l * NB + nseq) * 4 + hd) * 128 + dq * 32) * 256 + dv * 16 + v
                             : F.out + O_SGLA + (((size_t)(l * NDEC + nseq) * 4 + hd) * 128 + dq * 32) * 256 + dv * 16 + v;
        if (prompt) {
#pragma unroll
            for (int i = 0; i < 32; ++i) S[i] = 0.f; }
        else { const float* sin_ = F.in[I_GLA] + (((size_t)(l * NDEC + nseq) * 4 + hd) * 128 + dq * 32) * 256 + dv * 16 + v;
#pragma unroll
            for (int i = 0; i < 32; ++i) S[i] = sin_[(size_t)i * 256]; }
        const bf16_t* qp = F.Z + (size_t)row0 * ZW + ZQB + hd * 128 + dq * 32;
        const bf16_t* kp = F.Z + (size_t)row0 * ZW + ZKB + hd * 128 + dq * 32;
        const bf16_t* vp = F.Z + (size_t)row0 * ZW + ZVB + hd * 256 + dv * 16 + v;
        const float* dp = F.DEC + (size_t)row0 * 512 + hd * 128 + dq * 32;
        u32x4 qn[4], kn[4]; f32x4 dn[8]; float vn;
#pragma unroll
        for (int c = 0; c < 4; ++c) { qn[c] = *(const u32x4*)(qp + c * 8); kn[c] = *(const u32x4*)(kp + c * 8); }
#pragma unroll
        for (int c = 0; c < 8; ++c) dn[c] = *(const f32x4*)(dp + c * 4);
        vn = bf2f(*vp);
        for (int t = 0; t < T; ++t) {
            u32x4 qc[4], kc[4]; f32x4 dc[8]; const float vv = vn;
#pragma unroll
            for (int c = 0; c < 4; ++c) { qc[c] = qn[c]; kc[c] = kn[c]; }
#pragma unroll
            for (int c = 0; c < 8; ++c) dc[c] = dn[c];
            if (t + 1 < T) { const size_t o = (size_t)(t + 1);
#pragma unroll
                for (int c = 0; c < 4; ++c) { qn[c] = *(const u32x4*)(qp + o * ZW + c * 8); kn[c] = *(const u32x4*)(kp + o * ZW + c * 8); }
#pragma unroll
                for (int c = 0; c < 8; ++c) dn[c] = *(const f32x4*)(dp + o * 512 + c * 4);
                vn = bf2f(vp[o * ZW]); }
            float o_ = 0.f;
#pragma unroll
            for (int c = 0; c < 4; ++c) {
                const unsigned qw[4] = {qc[c].x, qc[c].y, qc[c].z, qc[c].w}, kw[4] = {kc[c].x, kc[c].y, kc[c].z, kc[c].w};
#pragma unroll
                for (int j = 0; j < 4; ++j) { const int i = c * 8 + j * 2;
                    S[i] = dc[i >> 2][i & 3] * S[i] + bflo(kw[j]) * vv; o_ += bflo(qw[j]) * S[i];
                    S[i + 1] = dc[(i + 1) >> 2][(i + 1) & 3] * S[i + 1] + bfhi(kw[j]) * vv; o_ += bfhi(qw[j]) * S[i + 1]; }
            }
            o_ += __shfl_xor(o_, 16); o_ += __shfl_xor(o_, 32);
            if (F.lane < 16) F.GLAO[(size_t)(row0 + t) * 1024 + hd * 256 + dv * 16 + v] = o_;
        }
#pragma unroll
        for (int i = 0; i < 32; ++i) sout[(size_t)i * 256] = S[i];
    }
}
__device__ __forceinline__ void gla_post_phase(const Frame& F, int l) {
    const float* go = F.in[I_GOUT] + l * 256;
    for (int row = F.bid * NWAVE + F.wave; row < MREAL; row += F.G * NWAVE) {
#pragma unroll
        for (int hd = 0; hd < 4; ++hd) {
            const f32x4 o = *(const f32x4*)(F.GLAO + (size_t)row * 1024 + hd * 256 + F.lane * 4);
            float ss = o[0] * o[0] + o[1] * o[1] + o[2] * o[2] + o[3] * o[3];
            ss = wave_sum(ss);
            const float rs = 1.0f / sqrtf(ss * (1.0f / 256.0f) + EPS);
            const f32x4 g = *(const f32x4*)(go + F.lane * 4);
            const u32x2 rr = *(const u32x2*)(F.Z + (size_t)row * ZW + ZRB + hd * 256 + F.lane * 4);
            u32x2 w; w.x = cvt_pk_bf16(o[0] * rs * g[0] * bflo(rr.x), o[1] * rs * g[1] * bfhi(rr.x)); w.y = cvt_pk_bf16(o[2] * rs * g[2] * bflo(rr.y), o[3] * rs * g[3] * bfhi(rr.y));
            *(u32x2*)(F.Y + ((size_t)1 * MP + row) * 1024 + hd * 256 + F.lane * 4) = w;
        }
    }
}

__device__ __forceinline__ float dot64(const u32x4 (&qv)[8], const bf16_t* kp) {
    float s = 0.f;
#pragma unroll
    for (int c = 0; c < 8; ++c) { const u32x4 kv = *(const u32x4*)(kp + c * 8);
        s += bflo(qv[c].x) * bflo(kv.x) + bfhi(qv[c].x) * bfhi(kv.x) + bflo(qv[c].y) * bflo(kv.y) + bfhi(qv[c].y) * bfhi(kv.y)
           + bflo(qv[c].z) * bflo(kv.z) + bfhi(qv[c].z) * bfhi(kv.z) + bflo(qv[c].w) * bflo(kv.w) + bfhi(qv[c].w) * bfhi(kv.w); }
    return s;
}
template <bool PROMPT>
__device__ __forceinline__ void swa_naive_phase(const Frame& F, int l) {
    const float* sinks = F.in[I_SINK] + l * 16;
    if (PROMPT) for (int it = F.bid * NWAVE + F.wave; it < NB * TP * 16; it += F.G * NWAVE) {
        const int qh = it & 15, rt = it >> 4, nseq = rt / TP, t = rt - nseq * TP, kvh = qh >> 2;
        const size_t row = (size_t)nseq * TP + t;
        u32x4 qv[8];
#pragma unroll
        for (int c = 0; c < 8; ++c) qv[c] = *(const u32x4*)(F.Z + row * ZW + ZQC + qh * 64 + c * 8);
        float s[2];
#pragma unroll
        for (int hf = 0; hf < 2; ++hf) { const int idx = F.lane + 64 * hf, kt = t - 127 + idx; const bool valid = kt >= 0;
            const size_t krow = (size_t)nseq * TP + (valid ? kt : 0);
            const float dt_ = dot64(qv, F.Z + krow * ZW + ZKC + kvh * 64);
            s[hf] = valid ? dt_ + F.BIAS[qh * 128 + (127 - idx)] : -INFINITY; }
        const float sk = sinks[qh];
        const float m = fmaxf(wave_max(fmaxf(s[0], s[1])), sk);
        const float p0 = __expf(s[0] - m), p1 = __expf(s[1] - m);
        const float den = wave_sum(p0 + p1) + __expf(sk - m);
        float acc = 0.f;
        const bf16_t* vbase = F.Z + ((size_t)nseq * TP + (t - 127)) * ZW + ZVC + kvh * 64 + F.lane;
        const int i0 = (t >= 127) ? 0 : 127 - t;
        for (int idx = i0; idx < 64; ++idx) { const float pj = __uint_as_float(__builtin_amdgcn_readlane(__float_as_uint(p0), idx)); acc += pj * bf2f(vbase[(ptrdiff_t)idx * ZW]); }
        for (int idx = (i0 > 64 ? i0 : 64); idx < 128; ++idx) { const float pj = __uint_as_float(__builtin_amdgcn_readlane(__float_as_uint(p1), idx - 64)); acc += pj * bf2f(vbase[(ptrdiff_t)idx * ZW]); }
        F.Y[((size_t)2 * MP + row) * 1024 + qh * 64 + F.lane] = f2bf(acc / den);
    }
    for (int it = F.bid * NWAVE + F.wave; it < NDEC * 16; it += F.G * NWAVE) {
        const int qh = it & 15, n = it >> 4, kvh = qh >> 2;
        const size_t row = (size_t)ROWS_P + n;
        const float* ck = F.in[I_CK] + (size_t)(l * NDEC + n) * 128 * 256 + kvh * 64;
        const float* cv = F.in[I_CV] + (size_t)(l * NDEC + n) * 128 * 256 + kvh * 64;
        float qf[64];
#pragma unroll
        for (int c = 0; c < 8; ++c) { const u32x4 qq = *(const u32x4*)(F.Z + row * ZW + ZQC + qh * 64 + c * 8);
            qf[c * 8] = bflo(qq.x); qf[c * 8 + 1] = bfhi(qq.x); qf[c * 8 + 2] = bflo(qq.y); qf[c * 8 + 3] = bfhi(qq.y); qf[c * 8 + 4] = bflo(qq.z); qf[c * 8 + 5] = bfhi(qq.z); qf[c * 8 + 6] = bflo(qq.w); qf[c * 8 + 7] = bfhi(qq.w); }
        float s[2];
#pragma unroll
        for (int hf = 0; hf < 2; ++hf) { const int idx = F.lane + 1 + 64 * hf;
            float dt_ = 0.f;
            if (idx < 128) {
#pragma unroll
                for (int c = 0; c < 16; ++c) { const f32x4 kv = *(const f32x4*)(ck + (size_t)idx * 256 + c * 4); dt_ += qf[c * 4] * kv[0] + qf[c * 4 + 1] * kv[1] + qf[c * 4 + 2] * kv[2] + qf[c * 4 + 3] * kv[3]; }
            } else {
#pragma unroll
                for (int c = 0; c < 64; ++c) dt_ += qf[c] * bf2f(F.Z[row * ZW + ZKC + kvh * 64 + c]);
            }
            s[hf] = dt_ + F.BIAS[qh * 128 + (128 - idx)]; }
        const float sk = sinks[qh];
        const float m = fmaxf(wave_max(fmaxf(s[0], s[1])), sk);
        const float p0 = __expf(s[0] - m), p1 = __expf(s[1] - m);
        const float den = wave_sum(p0 + p1) + __expf(sk - m);
        float acc = 0.f;
        for (int j = 0; j < 64; ++j) { const float pj = __uint_as_float(__builtin_amdgcn_readlane(__float_as_uint(p0), j)); acc += pj * cv[(size_t)(j + 1) * 256 + F.lane]; }
        for (int j = 0; j < 63; ++j) { const float pj = __uint_as_float(__builtin_amdgcn_readlane(__float_as_uint(p1), j)); acc += pj * cv[(size_t)(j + 65) * 256 + F.lane]; }
        { const float pj = __uint_as_float(__builtin_amdgcn_readlane(__float_as_uint(p1), 63)); acc += pj * bf2f(F.Z[row * ZW + ZVC + kvh * 64 + F.lane]); }
        F.Y[((size_t)2 * MP + row) * 1024 + qh * 64 + F.lane] = f2bf(acc / den);
    }
    for (int idx = F.bid * NTHR + F.tid; idx < NB * 128 * 256; idx += F.G * NTHR) {
        const int c = idx & 255, j = (idx >> 8) & 127, b = idx >> 15;
        const size_t row = (size_t)b * TP + (TP - 128) + j;
        F.out[O_PSWK + (size_t)l * NB * 128 * 256 + idx] = bf2f(F.Z[row * ZW + ZKC + c]);
        F.out[O_PSWV + (size_t)l * NB * 128 * 256 + idx] = bf2f(F.Z[row * ZW + ZVC + c]);
    }
    for (int idx = F.bid * NTHR + F.tid; idx < NDEC * 128 * 256; idx += F.G * NTHR) {
        const int c = idx & 255, j = (idx >> 8) & 127, n = idx >> 15;
        const size_t row = (size_t)ROWS_P + n;
        float kv, vv;
        if (j < 127) { kv = F.in[I_CK][(size_t)l * NDEC * 128 * 256 + idx + 256]; vv = F.in[I_CV][(size_t)l * NDEC * 128 * 256 + idx + 256]; }
        else { kv = bf2f(F.Z[row * ZW + ZKC + c]); vv = bf2f(F.Z[row * ZW + ZVC + c]); }
        F.out[O_SSWK + (size_t)l * NDEC * 128 * 256 + idx] = kv;
        F.out[O_SSWV + (size_t)l * NDEC * 128 * 256 + idx] = vv;
    }
}

__device__ __forceinline__ void swa_fast_phase(const Frame& F, int l) {
    LAS float* ext = (LAS float*)F.lds;
    for (int i = F.tid; i < 16 * 192; i += NTHR) { const int hq = i / 192, dd = i - hq * 192 - 32; ext[i] = (dd >= 0 && dd < 128) ? F.BIAS[hq * 128 + dd] : -INFINITY; }
    __syncthreads();
    const int q = F.lane & 31, h = F.lane >> 5;
    for (int it = F.bid * NWAVE + F.wave; it < NB * 65 * 16; it += F.G * NWAVE) {
        const int qh = it & 15, tile = (it >> 4) % 65, b = it / (65 * 16), kvh = qh >> 2, t0 = tile * 32;
        const int tq = (t0 + q < TP) ? t0 + q : TP - 1;
        const size_t rowq = (size_t)b * TP + tq;
        bf16x8 Qf[4];
#pragma unroll
        for (int s = 0; s < 4; ++s) Qf[s] = *(const bf16x8*)(F.Z + rowq * ZW + ZQC + qh * 64 + 16 * s + 8 * h);
        const int kb0 = t0 - 128, blk_lo = (t0 < 128) ? (128 - t0) >> 5 : 0;
        float sc[5][16];
        const LAS float* ex = ext + qh * 192 + (160 + q - 4 * h - 155);
#pragma unroll
        for (int blk = 0; blk < 5; ++blk) {
            if (blk >= blk_lo) {
                const bf16_t* kp = F.Z + ((size_t)b * TP + kb0 + 32 * blk + q) * ZW + ZKC + kvh * 64 + 8 * h;
                f32x16 acc;
#pragma unroll
                for (int r = 0; r < 16; ++r) acc[r] = 0.f;
#pragma unroll
                for (int s = 0; s < 4; ++s) { const bf16x8 Kf = *(const bf16x8*)(kp + 16 * s); acc = __builtin_amdgcn_mfma_f32_32x32x16_bf16(Kf, Qf[s], acc, 0, 0, 0); }
#pragma unroll
                for (int r = 0; r < 16; ++r) sc[blk][r] = acc[r] + ex[155 - (32 * blk + (r & 3) + 8 * (r >> 2))];
            } else {
#pragma unroll
                for (int r = 0; r < 16; ++r) sc[blk][r] = -INFINITY;
            }
        }
        float m = -INFINITY;
#pragma unroll
        for (int blk = 0; blk < 5; ++blk)
#pragma unroll
            for (int r = 0; r < 16; ++r) m = fmaxf(m, sc[blk][r]);
        m = fmaxf(m, __shfl_xor(m, 32));
        const float sk = F.in[I_SINK][l * 16 + qh];
        m = fmaxf(m, sk);
        float sum = 0.f;
#pragma unroll
        for (int blk = 0; blk < 5; ++blk)
#pragma unroll
            for (int r = 0; r < 16; ++r) { const float p = __expf(sc[blk][r] - m); sc[blk][r] = p; sum += p; }
        sum += __shfl_xor(sum, 32);
        const float inv = 1.0f / (sum + __expf(sk - m));
        f32x16 O0, O1;
#pragma unroll
        for (int r = 0; r < 16; ++r) { O0[r] = 0.f; O1[r] = 0.f; }
        const bf16_t* vt0 = F.VT + (size_t)(kvh * 64 + q) * MP + (size_t)b * TP + kb0 + 4 * h;
#pragma unroll
        for (int blk = 0; blk < 5; ++blk) {
            if (blk >= blk_lo) {
#pragma unroll
                for (int s2 = 0; s2 < 2; ++s2) {
                    u32x4 pp; pp.x = pk_bf16(sc[blk][8 * s2 + 0], sc[blk][8 * s2 + 1]); pp.y = pk_bf16(sc[blk][8 * s2 + 2], sc[blk][8 * s2 + 3]);
                    pp.z = pk_bf16(sc[blk][8 * s2 + 4], sc[blk][8 * s2 + 5]); pp.w = pk_bf16(sc[blk][8 * s2 + 6], sc[blk][8 * s2 + 7]);
                    const bf16x8 Pf = __builtin_bit_cast(bf16x8, pp);
                    const bf16_t* vp = vt0 + 32 * blk + 16 * s2;
                    { const u32x2 a0 = *(const u32x2*)vp, a1 = *(const u32x2*)(vp + 8); u32x4 av; av.x = a0.x; av.y = a0.y; av.z = a1.x; av.w = a1.y;
                      O0 = __builtin_amdgcn_mfma_f32_32x32x16_bf16(__builtin_bit_cast(bf16x8, av), Pf, O0, 0, 0, 0); }
                    { const u32x2 a0 = *(const u32x2*)(vp + (size_t)32 * MP), a1 = *(const u32x2*)(vp + (size_t)32 * MP + 8); u32x4 av; av.x = a0.x; av.y = a0.y; av.z = a1.x; av.w = a1.y;
                      O1 = __builtin_amdgcn_mfma_f32_32x32x16_bf16(__builtin_bit_cast(bf16x8, av), Pf, O1, 0, 0, 0); }
                }
            }
        }
        if (t0 + q < TP) {
            bf16_t* yp = F.Y + ((size_t)2 * MP + rowq) * 1024 + qh * 64 + 4 * h;
#pragma unroll
            for (int g4 = 0; g4 < 4; ++g4) {
                u32x2 w0; w0.x = pk_bf16(O0[4 * g4] * inv, O0[4 * g4 + 1] * inv); w0.y = pk_bf16(O0[4 * g4 + 2] * inv, O0[4 * g4 + 3] * inv); *(u32x2*)(yp + 8 * g4) = w0;
                u32x2 w1; w1.x = pk_bf16(O1[4 * g4] * inv, O1[4 * g4 + 1] * inv); w1.y = pk_bf16(O1[4 * g4 + 2] * inv, O1[4 * g4 + 3] * inv); *(u32x2*)(yp + 32 + 8 * g4) = w1;
            }
        }
    }
    __syncthreads();
}

constexpr int S5_SL_STRIDE = 132, S5_XC_STRIDE = 136, S5_XC_OFF = 129 * S5_SL_STRIDE * 4 + 496;
__device__ __forceinline__ void s5_fast_phase(const Frame& F, int l) {
    LAS float* SL = (LAS float*)F.lds;
    LAS bf16_t* XC = (LAS bf16_t*)(F.lds + S5_XC_OFF);
    const int lane = F.lane, w = F.wave, r16 = lane & 15, kg = lane >> 4;
    for (int it = F.bid; it < NB * 64; it += F.G) {
        const int b = it >> 6, g = it & 63;
        const bf16_t* ubase = F.Z + (size_t)b * TP * ZW + ZU + g * 16 + 8 * (kg & 1);
        {
            const bf16_t* w1 = F.W1T + ((size_t)(l * 64 + g) * 128 + 16 * w + r16) * 256 + (kg >> 1) * 16 + 8 * (kg & 1);
            bf16x8 Bf[8];
#pragma unroll
            for (int kk = 0; kk < 8; ++kk) Bf[kk] = *(const bf16x8*)(w1 + 2 * kk * 16);
#pragma unroll 1
            for (int mb = 0; mb < 9; ++mb) {
                int c = 16 * mb + r16; c = c > 128 ? 128 : c;
                const bf16_t* up = ubase + (size_t)(c * 16 + (kg >> 1)) * ZW;
                f32x4 acc = {0.f, 0.f, 0.f, 0.f};
#pragma unroll
                for (int kk = 0; kk < 8; ++kk) { const bf16x8 Af = *(const bf16x8*)(up + (size_t)(2 * kk) * ZW); acc = __builtin_amdgcn_mfma_f32_16x16x32_bf16(Af, Bf[kk], acc, 0, 0, 0); }
#pragma unroll
                for (int r = 0; r < 4; ++r) { const int cc = 16 * mb + 4 * kg + r; if (cc < 129) SL[cc * S5_SL_STRIDE + 16 * w + r16] = acc[r]; }
            }
        }
        __syncthreads();
        if (w == 0) {
            const int gi = (l * 64 + g) * 64 + lane;
            const float a_r = F.A16[gi * 2], a_i = F.A16[gi * 2 + 1];
            float xr = 0.f, xi = 0.f;
            float sr = SL[lane], si = SL[64 + lane];
            for (int c = 0; c < 129; ++c) {
                XC[c * S5_XC_STRIDE + lane] = f2bf(xr); XC[c * S5_XC_STRIDE + 64 + lane] = f2bf(xi);
                const float csr = sr, csi = si;
                if (c + 1 < 129) { sr = SL[(c + 1) * S5_SL_STRIDE + lane]; si = SL[(c + 1) * S5_SL_STRIDE + 64 + lane]; }
                const float nr = a_r * xr - a_i * xi + csr, ni = a_r * xi + a_i * xr + csi; xr = nr; xi = ni;
            }
            F.out[O_PS5R + ((size_t)(l * NB + b) * 64 + g) * 64 + lane] = xr; F.out[O_PS5I + ((size_t)(l * NB + b) * 64 + g) * 64 + lane] = xi;
        } else if (w == 1) {
            for (int i = lane; i < 15 * S5_XC_STRIDE; i += 64) XC[129 * S5_XC_STRIDE + i] = 0;
        }
        __syncthreads();
        {
            const float dsk = F.in[I_SD][l * 1024 + g * 16 + r16];
#pragma unroll 1
            for (int ti = 0; ti < 2; ++ti) {
                const int t = ti ? 15 - w : w;
                f32x4 acc[9];
#pragma unroll
                for (int mb = 0; mb < 9; ++mb) acc[mb] = (f32x4){0.f, 0.f, 0.f, 0.f};
                const bf16_t* kl = F.KLAG + (size_t)(l * 64 + g) * 17 * 256 + r16 * 16 + 8 * (kg & 1);
                const int nkk = (t >> 1) + 1;
#pragma unroll 1
                for (int kk = 0; kk < nkk; ++kk) {
                    const int s = 2 * kk + (kg >> 1);
                    const bf16x8 Bf = *(const bf16x8*)(kl + (t - s + 1) * 256);
#pragma unroll
                    for (int mb = 0; mb < 9; ++mb) { int c = 16 * mb + r16; c = c > 128 ? 128 : c;
                        const bf16x8 Af = *(const bf16x8*)(ubase + (size_t)(c * 16 + s) * ZW);
                        acc[mb] = __builtin_amdgcn_mfma_f32_16x16x32_bf16(Af, Bf, acc[mb], 0, 0, 0); }
                }
                const bf16_t* w2 = F.W2T + (((size_t)(l * 64 + g) * 16 + t) * 16 + r16) * 128 + 8 * kg;
#pragma unroll
                for (int kk = 0; kk < 4; ++kk) {
                    const bf16x8 Bf = *(const bf16x8*)(w2 + 32 * kk);
#pragma unroll
                    for (int mb = 0; mb < 9; ++mb) { const bf16x8 Af = *(const LAS bf16x8*)(XC + (16 * mb + r16) * S5_XC_STRIDE + 32 * kk + 8 * kg);
                        acc[mb] = __builtin_amdgcn_mfma_f32_16x16x32_bf16(Af, Bf, acc[mb], 0, 0, 0); }
                }
#pragma unroll
                for (int mb = 0; mb < 9; ++mb)
#pragma unroll
                    for (int r = 0; r < 4; ++r) { const int cc = 16 * mb + 4 * kg + r;
                        if (cc < 129) { const size_t row = (size_t)b * TP + cc * 16 + t;
                            const float u = bf2f(F.Z[row * ZW + ZU + g * 16 + r16]);
                            F.ZS5[row * 1024 + g * 16 + r16] = f2bf(gelu_tanh(acc[mb][r] + dsk * u)); } }
            }
        }
        __syncthreads();
    }
}

__device__ __forceinline__ void gla_pre_fast_phase(const Frame& F, int l) {
    LAS bf16_t* QE = (LAS bf16_t*)F.lds;
    LAS bf16_t* KE = (LAS bf16_t*)(F.lds + 8704);
    LAS bf16_t* ATT = (LAS bf16_t*)(F.lds + 17408);
    LAS float* PART = (LAS float*)(F.lds + 19968);
    const int d = F.tid & 127, tg = F.tid >> 7, lane = F.lane, w = F.wave, r32 = lane & 31, h = lane >> 5;
    for (int it = F.bid; it < GLA_ITEMS; it += F.G) {
        const int c = it % GLA_NCH, bh = it / GLA_NCH, b = bh >> 2, hd = bh & 3;
        float wg[16];
#pragma unroll
        for (int r = 0; r < 16; ++r) wg[r] = F.in[I_WG2][(size_t)l * 16 * 512 + r * 512 + hd * 128 + d];
        const float bg = F.in[I_BG2][l * 512 + hd * 128 + d];
        float cs[8]; float run = 0.f;
#pragma unroll
        for (int i = 0; i < 8; ++i) {
            const int t = c * 32 + tg * 8 + i; const bool valid = t < TP; const size_t row = (size_t)b * TP + (valid ? t : TP - 1);
            float pre = bg;
#pragma unroll
            for (int q4 = 0; q4 < 4; ++q4) { const f32x4 a = *(const f32x4*)(F.AIN + row * 16 + q4 * 4); pre += a[0] * wg[q4 * 4] + a[1] * wg[q4 * 4 + 1] + a[2] * wg[q4 * 4 + 2] + a[3] * wg[q4 * 4 + 3]; }
            const float ls = valid ? (fminf(pre, 0.f) - log1pf(expf(-fabsf(pre)))) * 0.0625f : 0.f;
            run += ls; cs[i] = run;
        }
        PART[tg * 128 + d] = run;
        __syncthreads();
        float off = 0.f;
        if (tg > 0) off += PART[d];
        if (tg > 1) off += PART[128 + d];
        if (tg > 2) off += PART[256 + d];
#pragma unroll
        for (int i = 0; i < 8; ++i) {
            const int tl = tg * 8 + i, t = c * 32 + tl; const bool valid = t < TP; const size_t row = (size_t)b * TP + (valid ? t : TP - 1);
            const float bc = off + cs[i];
            const float qv = bf2f(F.Z[row * ZW + ZQB + hd * 128 + d]), kv = bf2f(F.Z[row * ZW + ZKB + hd * 128 + d]);
            QE[tl * 136 + d] = f2bf(qv * expf(bc)); KE[tl * 136 + d] = f2bf(valid ? kv * expf(-bc) : 0.f);
        }
        if (tg == 3) F.GCD[(size_t)it * 128 + d] = expf(off + cs[7]);
        __syncthreads();
        if (w == 0) {
            f32x16 acc;
#pragma unroll
            for (int r = 0; r < 16; ++r) acc[r] = 0.f;
#pragma unroll
            for (int ks = 0; ks < 8; ++ks) { const bf16x8 Af = *(const LAS bf16x8*)(QE + r32 * 136 + 16 * ks + 8 * h), Bf = *(const LAS bf16x8*)(KE + r32 * 136 + 16 * ks + 8 * h);
                acc = __builtin_amdgcn_mfma_f32_32x32x16_bf16(Af, Bf, acc, 0, 0, 0); }
#pragma unroll
            for (int r = 0; r < 16; ++r) { const int t = (r & 3) + 8 * (r >> 2) + 4 * h; ATT[t * 40 + r32] = f2bf(r32 <= t ? acc[r] : 0.f); }
            asm volatile("s_waitcnt lgkmcnt(0)" ::: "memory");
#pragma unroll
            for (int s2 = 0; s2 < 2; ++s2) { const u32x4 v = *(const LAS u32x4*)(ATT + r32 * 40 + 16 * s2 + 8 * h); *(u32x4*)(F.GATT + ((size_t)it * 2 + s2) * 512 + lane * 8) = v; }
        }
        {
            const u32x2 lo = *(const LAS u32x2*)(QE + r32 * 136 + 16 * w + 4 * h), hi = *(const LAS u32x2*)(QE + r32 * 136 + 16 * w + 8 + 4 * h);
            *(u32x4*)(F.GQE + ((size_t)it * 8 + w) * 512 + lane * 8) = (u32x4){lo.x, lo.y, hi.x, hi.y};
        }
        {
            const int dd = 32 * (w >> 1) + r32, s0 = 16 * (w & 1) + 8 * h;
            unsigned e[8];
#pragma unroll
            for (int j = 0; j < 8; ++j) e[j] = KE[(s0 + j) * 136 + dd];
            *(u32x4*)(F.GKET + ((size_t)it * 8 + w) * 512 + lane * 8) = (u32x4){e[0] | (e[1] << 16), e[2] | (e[3] << 16), e[4] | (e[5] << 16), e[6] | (e[7] << 16)};
        }
#pragma unroll
        for (int s2 = 0; s2 < 2; ++s2) {
            unsigned e[8];
#pragma unroll
            for (int j = 0; j < 8; ++j) { const int t = c * 32 + 16 * s2 + 8 * h + j; e[j] = F.Z[((size_t)b * TP + t) * ZW + ZVB + hd * 256 + 32 * w + r32]; }
            *(u32x4*)(F.GV + (((size_t)it * 8 + w) * 2 + s2) * 512 + lane * 8) = (u32x4){e[0] | (e[1] << 16), e[2] | (e[3] << 16), e[4] | (e[5] << 16), e[6] | (e[7] << 16)};
        }
        __syncthreads();
    }
}
__device__ __forceinline__ void gla_chain_phase(const Frame& F, int l) {
    const int lane = F.lane, w = F.wave, r32 = lane & 31, h = lane >> 5;
    const int b = F.bid >> 2, hd = F.bid & 3;
    f32x16 S[4];
#pragma unroll
    for (int k = 0; k < 4; ++k)
#pragma unroll
        for (int r = 0; r < 16; ++r) S[k][r] = 0.f;
#pragma unroll 1
    for (int c = 0; c < GLA_NCH; ++c) {
        const size_t it = (size_t)(b * 4 + hd) * GLA_NCH + c;
        bf16x8 Qf[8], Kf[8], Af[2], Vf[2];
#pragma unroll
        for (int k = 0; k < 8; ++k) { Qf[k] = *(const bf16x8*)(F.GQE + (it * 8 + k) * 512 + lane * 8); Kf[k] = *(const bf16x8*)(F.GKET + (it * 8 + k) * 512 + lane * 8); }
#pragma unroll
        for (int s2 = 0; s2 < 2; ++s2) { Af[s2] = *(const bf16x8*)(F.GATT + (it * 2 + s2) * 512 + lane * 8); Vf[s2] = *(const bf16x8*)(F.GV + ((it * 8 + w) * 2 + s2) * 512 + lane * 8); }
        f32x16 o;
#pragma unroll
        for (int r = 0; r < 16; ++r) o[r] = 0.f;
#pragma unroll
        for (int ks = 0; ks < 8; ++ks) { const int k = ks >> 1, s2 = ks & 1;
            u32x4 pp; pp.x = pk_bf16(S[k][8 * s2], S[k][8 * s2 + 1]); pp.y = pk_bf16(S[k][8 * s2 + 2], S[k][8 * s2 + 3]); pp.z = pk_bf16(S[k][8 * s2 + 4], S[k][8 * s2 + 5]); pp.w = pk_bf16(S[k][8 * s2 + 6], S[k][8 * s2 + 7]);
            o = __builtin_amdgcn_mfma_f32_32x32x16_bf16(Qf[ks], __builtin_bit_cast(bf16x8, pp), o, 0, 0, 0); }
#pragma unroll
        for (int s2 = 0; s2 < 2; ++s2) o = __builtin_amdgcn_mfma_f32_32x32x16_bf16(Af[s2], Vf[s2], o, 0, 0, 0);
#pragma unroll
        for (int k = 0; k < 4; ++k) {
#pragma unroll
            for (int s2 = 0; s2 < 2; ++s2) S[k] = __builtin_amdgcn_mfma_f32_32x32x16_bf16(Kf[2 * k + s2], Vf[s2], S[k], 0, 0, 0);
#pragma unroll
            for (int g4 = 0; g4 < 4; ++g4) { const f32x4 cd = *(const f32x4*)(F.GCD + it * 128 + 32 * k + 8 * g4 + 4 * h);
                S[k][4 * g4] *= cd[0]; S[k][4 * g4 + 1] *= cd[1]; S[k][4 * g4 + 2] *= cd[2]; S[k][4 * g4 + 3] *= cd[3]; }
        }
#pragma unroll
        for (int r = 0; r < 16; ++r) { const int t = c * 32 + (r & 3) + 8 * (r >> 2) + 4 * h;
            if (t < TP) F.GLAO[((size_t)b * TP + t) * 1024 + hd * 256 + 32 * w + r32] = o[r]; }
    }
    float* so = F.out + O_PGLA + ((size_t)(l * NB + b) * 4 + hd) * 128 * 256 + 32 * w + r32;
#pragma unroll
    for (int k = 0; k < 4; ++k)
#pragma unroll
        for (int r = 0; r < 16; ++r) so[(size_t)(32 * k + (r & 3) + 8 * (r >> 2) + 4 * h) * 256] = S[k][r];
}

constexpr int NPH = 11, PH_FINAL = 1 + DEPTH * NPH, N_PHASES = PH_FINAL + 1;
#ifndef N_LAUNCH_MODE
#define N_LAUNCH_MODE 1
#endif

__global__ void __launch_bounds__(NTHR, 2) mega(Args a) {
    extern __shared__ __attribute__((aligned(16))) unsigned char lds_raw[];
    Frame F;
    F.in = a.in; F.out = a.out; F.ws = a.ws; F.lds = (LAS unsigned char*)lds_raw;
    F.tid = threadIdx.x; F.lane = F.tid & 63; F.wave = __builtin_amdgcn_readfirstlane(F.tid >> 6); F.G = gridDim.x; F.bid = blockIdx.x;
    unsigned char* ws = a.ws;
    F.Wt_in = (bf16_t*)(ws + WS_WIN); F.Wt_glu = (bf16_t*)(ws + WS_WGLU); F.Wt_up = (bf16_t*)(ws + WS_WUP); F.Wt_out = (bf16_t*)(ws + WS_WOUT); F.Wt_ff1 = (bf16_t*)(ws + WS_WFF1); F.Wt_ff2 = (bf16_t*)(ws + WS_WFF2);
    F.X = (float*)(ws + WS_X); F.H = (bf16_t*)(ws + WS_H); F.AIN = (float*)(ws + WS_AIN); F.Z = (bf16_t*)(ws + WS_Z); F.ZS5 = (bf16_t*)(ws + WS_ZS5); F.Y = (bf16_t*)(ws + WS_Y);
    F.GLAO = (float*)(ws + WS_GLAO); F.DEC = (float*)(ws + WS_DEC); F.MRG = (float*)(ws + WS_MRG); F.MERGED = (bf16_t*)(ws + WS_MERGED); F.MIX = (float*)(ws + WS_MIX); F.FFH = (bf16_t*)(ws + WS_Z);
    F.S5A = (float*)(ws + WS_S5A); F.S5B = (float*)(ws + WS_S5B); F.BIAS = (float*)(ws + WS_BIAS); F.VT = (bf16_t*)(ws + WS_VT); F.W1T = (bf16_t*)(ws + WS_W1T); F.W2T = (bf16_t*)(ws + WS_W2T); F.KLAG = (bf16_t*)(ws + WS_KLAG); F.A16 = (float*)(ws + WS_A16); F.GQE = (bf16_t*)(ws + WS_GQE); F.GKET = (bf16_t*)(ws + WS_GKET); F.GATT = (bf16_t*)(ws + WS_GATT); F.GV = (bf16_t*)(ws + WS_GV); F.GCD = (float*)(ws + WS_GCD);

    LAS unsigned* misc = (LAS unsigned*)(F.lds + LDS_MISC_OFF);
    if (F.tid < 4) misc[F.tid] = 0u;
    __syncthreads();
    const int lo = a.ph_lo, hi = a.ph_hi;
    XcdBarrier bar; bar.bar = (unsigned*)(ws + WS_CTL); bar.x = 0; bar.st = (volatile LAS unsigned*)misc;
    if (hi - lo > 1) bar = xcd_barrier_post((unsigned*)(ws + WS_CTL), (volatile LAS unsigned*)misc);
#ifndef PHMASK
#define PHMASK 0xFFFF
#endif
#define ON(i) (((PHMASK) >> (i)) & 1)
#ifndef REPMASK
#define REPMASK 0
#endif
#define REP(i) for (int rep_ = 0; rep_ < 1 + (((REPMASK) >> (i)) & 1); ++rep_)
#define IN(k) (lo <= (k) && (k) < hi)
#define SEAM(k) do { if (IN(k) && IN((k) + 1)) xcd_barrier(bar); } while (0)

    if (ON(12) && IN(0)) { F.fresh(); prologue_phase(F); }
    SEAM(0);
    for (int l = 0; l < DEPTH; ++l) {
        const int pb = 1 + l * NPH;
#define FRESH() do { if (REPMASK) __syncthreads(); F.fresh(); } while (0)
        if (ON(0) && IN(pb + 0)) REP(0) { FRESH(); if (l == 0) norm_phase<0>(F, 0); else norm_phase<2>(F, l); }
        SEAM(pb + 0);
        if (ON(1) && IN(pb + 1)) REP(1) { FRESH();
            pg8::Gemm g{F.H, F.Wt_in + (size_t)l * ZW * D, MP, ZW, D}; pg8::StaticOrder S; S.init(MP, ZW, F.G, F.bid);
            pg8::EpiIn E{F.Z, ZW, F.VT, MP};
            pg8::gemm_phase<pg8::EpiIn, pg8::StaticOrder>(F.lds, g, S, E, nullptr);
        }
        SEAM(pb + 1);
        if (ON(2) && IN(pb + 2)) REP(2) { FRESH(); gla_pre_phase(F, l); s5_naive_phase<false>(F, l); swa_naive_phase<false>(F, l); __syncthreads(); gla_pre_fast_phase(F, l); s5_fast_phase(F, l); swa_fast_phase(F, l); }
        SEAM(pb + 2);
        if (ON(3) && IN(pb + 3)) REP(3) { FRESH();
            if (F.bid < 16) gla_chain_phase(F, l);
            else {
                gla_naive_phase(F, l, 16);
                pg8::Gemm g{F.ZS5, F.Wt_glu + (size_t)l * 1024 * 1024, MP, 1024, 1024}; pg8::StaticOrder S; S.init(MP, 1024, F.G - 16, F.bid - 16);
                pg8::EpiGlu E{F.Y, F.ZS5, F.in[I_BGLU] + l * 1024, 1024};
                pg8::gemm_phase<pg8::EpiGlu, pg8::StaticOrder>(F.lds, g, S, E, nullptr);
            } }
        SEAM(pb + 3);
        if (ON(4) && IN(pb + 4)) REP(4) { FRESH(); gla_post_phase(F, l); }
        SEAM(pb + 4);
        if (ON(6) && IN(pb + 6)) REP(6) { FRESH();
            pg8::StaticOrder S; S.init(MP, D, F.G, F.bid);
            { pg8::Gemm g{F.Y, F.Wt_up + ((size_t)l * 3 + 0) * D * 1024, MP, D, 1024}; pg8::EpiMerge<0> E{F.MRG, F.MERGED, F.Z + ZG, ZW}; pg8::gemm_phase<pg8::EpiMerge<0>, pg8::StaticOrder>(F.lds, g, S, E, nullptr); }
            { pg8::Gemm g{F.Y + (size_t)MP * 1024, F.Wt_up + ((size_t)l * 3 + 1) * D * 1024, MP, D, 1024}; pg8::EpiMerge<1> E{F.MRG, F.MERGED, F.Z + ZG + 2048, ZW}; pg8::gemm_phase<pg8::EpiMerge<1>, pg8::StaticOrder>(F.lds, g, S, E, nullptr); }
            { pg8::Gemm g{F.Y + (size_t)2 * MP * 1024, F.Wt_up + ((size_t)l * 3 + 2) * D * 1024, MP, D, 1024}; pg8::EpiMerge<2> E{F.MRG, F.MERGED, F.Z + ZG + 4096, ZW}; pg8::gemm_phase<pg8::EpiMerge<2>, pg8::StaticOrder>(F.lds, g, S, E, nullptr); }
        }
        SEAM(pb + 6);
        if (ON(7) && IN(pb + 7)) REP(7) { FRESH();
            pg8::Gemm g{F.MERGED, F.Wt_out + (size_t)l * D * D, MP, D, D}; pg8::StaticOrder S; S.init(MP, D, F.G, F.bid);
            pg8::EpiF32 E{F.MIX, D};
            pg8::gemm_phase<pg8::EpiF32, pg8::StaticOrder>(F.lds, g, S, E, nullptr);
        }
        SEAM(pb + 7);
        if (ON(8) && IN(pb + 8)) REP(8) { FRESH(); norm_phase<1>(F, l); }
        SEAM(pb + 8);
        if (ON(9) && IN(pb + 9)) REP(9) { FRESH();
            pg8::Gemm g{F.H, F.Wt_ff1 + (size_t)l * DFF * D, MP, DFF, D}; pg8::StaticOrder S; S.init(MP, DFF, F.G, F.bid);
            pg8::EpiFF1 E{F.FFH, DFF};
            pg8::gemm_phase<pg8::EpiFF1, pg8::StaticOrder>(F.lds, g, S, E, nullptr);
        }
        SEAM(pb + 9);
        if (ON(10) && IN(pb + 10)) REP(10) { FRESH();
            pg8::Gemm g{F.FFH, F.Wt_ff2 + (size_t)l * D * DFF, MP, D, DFF}; pg8::StaticOrder S; S.init(MP, D, F.G, F.bid);
            pg8::EpiF32 E{F.MIX, D};
            pg8::gemm_phase<pg8::EpiF32, pg8::StaticOrder>(F.lds, g, S, E, nullptr);
        }
        SEAM(pb + 10);
    }
    if (ON(11) && IN(PH_FINAL)) { F.fresh(); norm_phase<3>(F, DEPTH); }
#undef IN
#undef SEAM
}

extern "C" void kernel_launch(void* const* d_in, const int* in_sizes, int n_in, void* d_out, int out_size, void* d_ws, size_t ws_size, hipStream_t stream) {
    static int grid = 0;
    if (grid == 0) {
        if (n_in != N_IN || (size_t)out_size != O_END || ws_size < WS_END) {
            fprintf(stderr, "kernel_launch: expected %d inputs, %zu outputs, >= %zu bytes of workspace; got %d, %d, %zu; nothing launched\n", (int)N_IN, (size_t)O_END, (size_t)WS_END, n_in, out_size, ws_size); grid = -1; return; }
        int dev = 0, cus = 0, per_cu = 0;
        if (hipGetDevice(&dev) != hipSuccess || hipDeviceGetAttribute(&cus, hipDeviceAttributeMultiprocessorCount, dev) != hipSuccess) { fprintf(stderr, "kernel_launch: device query failed\n"); grid = -1; return; }
        if (hipFuncSetAttribute((const void*)mega, hipFuncAttributeMaxDynamicSharedMemorySize, LDS_BYTES) != hipSuccess) { fprintf(stderr, "kernel_launch: hipFuncSetAttribute failed\n"); grid = -1; return; }
        if (hipOccupancyMaxActiveBlocksPerMultiprocessor(&per_cu, (const void*)mega, NTHR, LDS_BYTES) != hipSuccess || per_cu < 1) { fprintf(stderr, "kernel_launch: occupancy query says %d blocks per CU\n", per_cu); }
        (void)hipGetLastError();
        grid = cus;
        if (grid > 256) grid = 256;
    }
    if (grid < 0) return;
    if (hipMemsetAsync((char*)d_ws + WS_CTL, 0, WS_CTL_BYTES, stream) != hipSuccess) { fprintf(stderr, "kernel_launch: memset failed\n"); return; }
    Args a{};
    for (int i = 0; i < N_IN; ++i) a.in[i] = (const float*)d_in[i];
    a.out = (float*)d_out; a.ws = (unsigned char*)d_ws;
#if N_LAUNCH_MODE == 1
    a.ph_lo = 0; a.ph_hi = N_PHASES;
    hipLaunchKernelGGL(mega, dim3(grid), dim3(NTHR), LDS_BYTES, stream, a);
#else
    for (int ph = 0; ph < N_PHASES; ++ph) { a.ph_lo = ph; a.ph_hi = ph + 1; hipLaunchKernelGGL(mega, dim3(grid), dim3(NTHR), LDS_BYTES, stream, a); }
#endif
    const hipError_t le = hipPeekAtLastError();
    if (le != hipSuccess) fprintf(stderr, "kernel_launch: launch failed: %s\n", hipGetErrorName(le));
}
```
